# Optimizing an MI355X kernel written in HIP

```python
import math
import jax, jax.numpy as jnp
from jax import lax
import numpy as np

D_MODEL = 1024
BATCH = 8
SEQ = 2048
DEPTH = 1
DEC_BATCH = 32
DEC_SEQ = 1
PAST_LEN = 8192
PAGE_SIZE = 128

MIX_WIDTH = D_MODEL
W_DIFF = MIX_WIDTH // 2
W_DELTA = MIX_WIDTH - W_DIFF
H_DIFF = 4
DH_DIFF = W_DIFF // (2 * H_DIFF)
DV_DIFF = 2 * DH_DIFF
H_DELTA = 4
DK_DELTA = W_DELTA // H_DELTA
DV_DELTA = W_DELTA // H_DELTA
ROT_DIM = DH_DIFF // 4
ROPE_THETA = 500000.0
CONV_W = 4
CONV_CH = 3 * W_DELTA
CHUNK = 64
Q_BLOCK = 128
OFF_DQ = 0
OFF_DK = OFF_DQ + W_DIFF
OFF_DV = OFF_DK + W_DIFF
OFF_DG = OFF_DV + W_DIFF
OFF_LQ = OFF_DG + W_DIFF
OFF_LK = OFF_LQ + W_DELTA
OFF_LV = OFF_LK + W_DELTA
OFF_LZ = OFF_LV + W_DELTA
OFF_LB = OFF_LZ + W_DELTA
OFF_LA = OFF_LB + H_DELTA
P_IN = OFF_LA + H_DELTA
DEEPNORM_ALPHA = (2 * DEPTH) ** 0.25
DEEPNORM_BETA = (8 * DEPTH) ** -0.25
LN_EPS = 1e-5
HEAD_NORM_EPS = 1e-5
DELTA_NORM_EPS = 1e-6
L2_EPS = 1e-6
NEG_INF = -1e30

kernel_name = 'hymba_diffattn_gated_deltanet_step'


def lambda_init_for(layer):
    return 0.8 - 0.6 * math.exp(-0.3 * layer)


def rms_norm(x, w, eps):
    xf = x.astype(jnp.float32)
    return xf * lax.rsqrt(jnp.mean(xf * xf, axis=-1, keepdims=True) + eps) * w.astype(jnp.float32)


def layer_norm(x, g, b):
    xf = x.astype(jnp.float32)
    mu = jnp.mean(xf, axis=-1, keepdims=True)
    var = jnp.mean(jnp.square(xf - mu), axis=-1, keepdims=True)
    return ((xf - mu) * lax.rsqrt(var + LN_EPS) * g.astype(jnp.float32) + b.astype(jnp.float32)).astype(x.dtype)


def l2_normalize(x):
    xf = x.astype(jnp.float32)
    return xf * lax.rsqrt(jnp.sum(xf * xf, axis=-1, keepdims=True) + L2_EPS)


def rope_partial(x, pos):
    half = ROT_DIM // 2
    inv = ROPE_THETA ** (-jnp.arange(half, dtype=jnp.float32) / half)
    ang = pos.astype(jnp.float32)[:, None] * inv[None, :]
    cos = jnp.cos(ang)[None, :, None, None, :]
    sin = jnp.sin(ang)[None, :, None, None, :]
    xf = x.astype(jnp.float32)
    x1, x2, rest = xf[..., :half], xf[..., half:ROT_DIM], xf[..., ROT_DIM:]
    out = jnp.concatenate([x1 * cos - x2 * sin, x2 * cos + x1 * sin, rest], axis=-1)
    return out.astype(x.dtype)


def diff_attention(q, q_pos, segments, lam):
    qf = q.astype(jnp.float32) * DH_DIFF ** -0.5
    s = jnp.concatenate([jnp.einsum('bqhmd,bkhmd->bhmqk', qf, k.astype(jnp.float32)) for k, _, _ in segments], axis=-1)
    k_pos = jnp.concatenate([kp for _, _, kp in segments])
    s = jnp.where(k_pos[None, :] <= q_pos[:, None], s, NEG_INF)
    p = jax.nn.softmax(s, axis=-1)
    a = p[:, :, 0] - lam * p[:, :, 1]
    out = None
    start = 0
    for _, v, kp in segments:
        n = kp.shape[0]
        part = jnp.einsum('bhqk,bkhe->bqhe', a[..., start:start + n], v.astype(jnp.float32))
        out = part if out is None else out + part
        start += n
    return out


def prompt_diff_attention(q, k, v, pos, lam):
    B, T = q.shape[0], q.shape[1]
    nb = T // Q_BLOCK
    qb = q.reshape((B, nb, Q_BLOCK) + q.shape[2:]).swapaxes(0, 1)
    pb = pos.reshape(nb, Q_BLOCK)
    out = lax.map(lambda a: diff_attention(a[0], a[1], [(k, v, pos)], lam), (qb, pb))
    return out.swapaxes(0, 1).reshape(B, T, H_DIFF, DV_DIFF)


def causal_conv(u, prev, w):
    T = u.shape[1]
    xp = jnp.concatenate([prev.astype(u.dtype), u], axis=1)
    out = xp[:, 0:T] * w[0]
    for j in range(1, CONV_W):
        out = out + xp[:, j:j + T] * w[j]
    return jax.nn.silu(out), xp[:, xp.shape[1] - (CONV_W - 1):]


def gated_delta_rule(q, k, v, g, beta, s0):
    B, T, H, DK = q.shape
    DV = v.shape[-1]
    pad = (-T) % CHUNK
    n = (T + pad) // CHUNK

    def chunks_vec(a):
        a = jnp.pad(a.astype(jnp.float32), [(0, 0), (0, pad), (0, 0), (0, 0)])
        return a.reshape(B, n, CHUNK, H, a.shape[-1]).transpose(1, 0, 3, 2, 4)

    def chunks_scalar(a):
        a = jnp.pad(a.astype(jnp.float32), [(0, 0), (0, pad), (0, 0)])
        return a.reshape(B, n, CHUNK, H).transpose(1, 0, 3, 2)

    qc = chunks_vec(q) * DK ** -0.5
    kc = chunks_vec(k)
    vc = chunks_vec(v)
    bc = chunks_scalar(beta)
    gc = jnp.cumsum(chunks_scalar(g), axis=-1)
    idx = jnp.arange(CHUNK)
    incl = idx[:, None] >= idx[None, :]
    strict = idx[:, None] > idx[None, :]
    decay = jnp.exp(jnp.where(incl, gc[..., :, None] - gc[..., None, :], -jnp.inf))
    kb = kc * bc[..., None]
    a_mat = jnp.where(strict, jnp.einsum('nbhcd,nbhed->nbhce', kb, kc) * decay, 0.0)
    eye = jnp.eye(CHUNK, dtype=jnp.float32)
    t_mat = lax.linalg.triangular_solve(a_mat + eye, jnp.broadcast_to(eye, a_mat.shape),
                                        left_side=True, lower=True, unit_diagonal=True)
    u = t_mat @ (vc * bc[..., None])
    w = t_mat @ (kb * jnp.exp(gc)[..., None])

    def step(S, inp):
        q_i, k_i, u_i, w_i, g_i, d_i = inp
        v_new = u_i - w_i @ S
        attn = jnp.where(incl, (q_i @ jnp.swapaxes(k_i, -1, -2)) * d_i, 0.0)
        o = (q_i * jnp.exp(g_i)[..., None]) @ S + attn @ v_new
        g_last = g_i[..., -1]
        S = S * jnp.exp(g_last)[..., None, None] + jnp.einsum(
            'bhck,bhcv->bhkv', k_i * jnp.exp(g_last[..., None] - g_i)[..., None], v_new)
        return S, o

    S, o = lax.scan(step, s0.astype(jnp.float32), (qc, kc, u, w, gc, decay))
    o = o.transpose(1, 0, 3, 2, 4).reshape(B, n * CHUNK, H, DV)[:, :T]
    return o, S


def hybrid_layer(x, pos, lam_init, attend, conv_prev, s_prev,
                 w_in, conv_w, a_log, dt_bias, delta_norm_w, diff_lambda, diff_norm_w, w_out, ln_g, ln_b):
    B, T, _ = x.shape
    h = jnp.einsum('btd,dp->btp', x, w_in)
    q = rope_partial(h[..., OFF_DQ:OFF_DK].reshape(B, T, H_DIFF, 2, DH_DIFF), pos)
    k = rope_partial(h[..., OFF_DK:OFF_DV].reshape(B, T, H_DIFF, 2, DH_DIFF), pos)
    v = h[..., OFF_DV:OFF_DG].reshape(B, T, H_DIFF, DV_DIFF)
    gate_a = h[..., OFF_DG:OFF_LQ]
    lam_p = diff_lambda.astype(jnp.float32)
    lam = jnp.exp(jnp.sum(lam_p[0] * lam_p[1])) - jnp.exp(jnp.sum(lam_p[2] * lam_p[3])) + lam_init
    o_a = attend(q, k, v, lam)
    o_a = rms_norm(o_a, diff_norm_w, HEAD_NORM_EPS) * (1.0 - lam_init)
    o_a = o_a.reshape(B, T, W_DIFF).astype(x.dtype) * jax.nn.silu(gate_a)
    c, conv_new = causal_conv(h[..., OFF_LQ:OFF_LZ], conv_prev, conv_w)
    lq = l2_normalize(c[..., 0:W_DELTA].reshape(B, T, H_DELTA, DK_DELTA))
    lk = l2_normalize(c[..., W_DELTA:2 * W_DELTA].reshape(B, T, H_DELTA, DK_DELTA))
    lv = c[..., 2 * W_DELTA:].reshape(B, T, H_DELTA, DV_DELTA)
    gate_b = h[..., OFF_LZ:OFF_LB]
    beta = jax.nn.sigmoid(h[..., OFF_LB:OFF_LA].astype(jnp.float32))
    g = -jnp.exp(a_log.astype(jnp.float32)) * jax.nn.softplus(
        h[..., OFF_LA:P_IN].astype(jnp.float32) + dt_bias.astype(jnp.float32))
    o_b, s_new = gated_delta_rule(lq, lk, lv, g, beta, s_prev)
    o_b = rms_norm(o_b, delta_norm_w, DELTA_NORM_EPS).reshape(B, T, W_DELTA).astype(x.dtype) * jax.nn.silu(gate_b)
    mix = jnp.einsum('btw,wd->btd', jnp.concatenate([o_a, o_b], axis=-1), w_out)
    y = layer_norm(DEEPNORM_ALPHA * x + mix, ln_g, ln_b)
    return y, k, v.astype(x.dtype), s_new, conv_new


def setup_inputs(seed: int = 0) -> dict:
    key = jax.random.key(seed)
    ks = jax.random.split(key, 20)
    f32 = jnp.float32
    n_pages = PAST_LEN // PAGE_SIZE
    used = DEC_BATCH * n_pages
    n_phys = used + max(1, used // 4)
    x_prompt = jax.random.normal(ks[0], (BATCH, SEQ, D_MODEL), f32)
    x_sample = jax.random.normal(ks[1], (DEC_BATCH, DEC_SEQ, D_MODEL), f32)
    cache_k = jax.random.normal(ks[2], (DEPTH, n_phys, PAGE_SIZE, H_DIFF, 2, DH_DIFF), f32)
    cache_v = jax.random.normal(ks[3], (DEPTH, n_phys, PAGE_SIZE, H_DIFF, DV_DIFF), f32)
    page_table = jax.random.permutation(ks[4], n_phys)[:used].reshape(DEC_BATCH, n_pages).astype(jnp.int32)
    state_delta = 0.1 * jax.random.normal(ks[5], (DEPTH, DEC_BATCH, H_DELTA, DK_DELTA, DV_DELTA), f32)
    state_conv = jax.random.normal(ks[6], (DEPTH, DEC_BATCH, CONV_W - 1, CONV_CH), f32)
    w_in = jax.random.normal(ks[7], (DEPTH, D_MODEL, P_IN), f32) * D_MODEL ** -0.5
    conv_w = jax.random.normal(ks[8], (DEPTH, CONV_W, CONV_CH), f32) * CONV_W ** -0.5
    a_log = jnp.log(jax.random.uniform(ks[9], (DEPTH, H_DELTA), f32, minval=1.0, maxval=16.0))
    dt = jnp.exp(jax.random.uniform(ks[10], (DEPTH, H_DELTA), f32) * (math.log(0.1) - math.log(0.001)) + math.log(0.001))
    dt_bias = dt + jnp.log(-jnp.expm1(-dt))
    delta_norm_w = 1.0 + 0.02 * jax.random.normal(ks[11], (DEPTH, DV_DELTA), f32)
    diff_lambda = 0.1 * jax.random.normal(ks[12], (DEPTH, 4, DH_DIFF), f32)
    diff_norm_w = 1.0 + 0.02 * jax.random.normal(ks[13], (DEPTH, DV_DIFF), f32)
    w_out = jax.random.normal(ks[14], (DEPTH, MIX_WIDTH, D_MODEL), f32) * (MIX_WIDTH ** -0.5 * DEEPNORM_BETA)
    ln_g = 1.0 + 0.02 * jax.random.normal(ks[15], (DEPTH, D_MODEL), f32)
    ln_b = 0.02 * jax.random.normal(ks[16], (DEPTH, D_MODEL), f32)
    return {'x_prompt': x_prompt, 'x_sample': x_sample, 'cache_k': cache_k, 'cache_v': cache_v,
            'page_table': page_table, 'state_delta': state_delta, 'state_conv': state_conv,
            'w_in': w_in, 'conv_w': conv_w, 'a_log': a_log, 'dt_bias': dt_bias, 'delta_norm_w': delta_norm_w,
            'diff_lambda': diff_lambda, 'diff_norm_w': diff_norm_w, 'w_out': w_out, 'ln_g': ln_g, 'ln_b': ln_b}


def reference(x_prompt, x_sample, cache_k, cache_v, page_table, state_delta, state_conv,
              w_in, conv_w, a_log, dt_bias, delta_norm_w, diff_lambda, diff_norm_w, w_out, ln_g, ln_b):
    Bp, Tp = x_prompt.shape[0], x_prompt.shape[1]
    Bs, Ts = x_sample.shape[0], x_sample.shape[1]
    past_len = page_table.shape[1] * cache_k.shape[2]
    pos_p = jnp.arange(Tp, dtype=jnp.int32)
    pos_s = past_len + jnp.arange(Ts, dtype=jnp.int32)
    pos_past = jnp.arange(past_len, dtype=jnp.int32)
    hp, hs = x_prompt, x_sample
    kp_l, vp_l, sp_l, cp_l, ks_l, vs_l, ss_l, cs_l = [], [], [], [], [], [], [], []
    for l in range(DEPTH):
        lam_init = lambda_init_for(l)
        params = (w_in[l], conv_w[l], a_log[l], dt_bias[l], delta_norm_w[l], diff_lambda[l],
                  diff_norm_w[l], w_out[l], ln_g[l], ln_b[l])
        attend_p = lambda q, k, v, lam: prompt_diff_attention(q, k, v, pos_p, lam)
        conv0 = jnp.zeros((Bp, CONV_W - 1, CONV_CH), hp.dtype)
        s0 = jnp.zeros((Bp, H_DELTA, DK_DELTA, DV_DELTA), jnp.float32)
        hp, kp, vp, sp, cp = hybrid_layer(hp, pos_p, lam_init, attend_p, conv0, s0, *params)
        pk = cache_k[l, page_table].reshape(Bs, past_len, H_DIFF, 2, DH_DIFF)
        pv = cache_v[l, page_table].reshape(Bs, past_len, H_DIFF, DV_DIFF)
        def attend_s(q, k, v, lam, pk=pk, pv=pv):
            return diff_attention(q, pos_s, [(pk, pv, pos_past), (k, v, pos_s)], lam)
        hs, ksn, vsn, ssn, csn = hybrid_layer(hs, pos_s, lam_init, attend_s, state_conv[l], state_delta[l], *params)
        kp_l.append(kp); vp_l.append(vp); sp_l.append(sp); cp_l.append(cp)
        ks_l.append(ksn); vs_l.append(vsn); ss_l.append(ssn); cs_l.append(csn)
    return (hp, hs, jnp.stack(kp_l), jnp.stack(vp_l), jnp.stack(sp_l), jnp.stack(cp_l),
            jnp.stack(ks_l), jnp.stack(vs_l), jnp.stack(ss_l), jnp.stack(cs_l))
```

```cpp
#include <hip/hip_runtime.h>
#include <cstdio>
#include <cstdint>
#include <cmath>
namespace pg8 {
#define PG8_LAS __attribute__((address_space(3)))
typedef unsigned short bf16_t;
typedef short bf16x8 __attribute__((ext_vector_type(8)));
typedef float f32x4 __attribute__((ext_vector_type(4)));
typedef unsigned u32x4 __attribute__((ext_vector_type(4)));
constexpr int BM = 256, BK = 64, HALF = 128, HTB = HALF * BK * 2  , STAGE_BYTES = 8 * HTB, NXCD = 8, WGM = 8;

__host__ __device__ __forceinline__ int lds_byte(int r, int c) { const int st = (r >> 4) * 2 + (c >> 5), rr = r & 15, cc = c & 31, ob = rr * 64 + cc * 2; return st * 1024 + (ob ^ (((ob >> 9) & 1) << 5)); }
__host__ __device__ __forceinline__ void stage_rc(int b, int& R, int& C) { const int st = b / 1024, sb = b % 1024, swz = sb ^ (((sb >> 9) & 1) << 5); R = (st >> 1) * 16 + swz / 64; C = (st & 1) * 32 + (swz % 64) / 2; }
__host__ __device__ __forceinline__ int perm32(int rho) { const int n = rho >> 4, i = rho & 15; return 8 * (i >> 2) + 4 * n + (i & 3); }

struct Unit { int pm, pn; };
struct Gemm { const bf16_t* A; const bf16_t* Bt; int M, N, K; };

struct StaticOrder {
    int nM, nN, nwg, G, c;
    __host__ __device__ void init(int M, int N, int G_, int c_) { nM = M / BM; nN = N / BM; nwg = nM * nN; G = G_; c = c_; }
    __host__ __device__ bool next(int i, Unit& u) const {
        const long L = (long)i * G + c; if (L >= nwg) return false;
        int wgid = (int)L; { const int q = nwg / NXCD, r = nwg % NXCD, xcd = wgid % NXCD, off = wgid / NXCD; wgid = (xcd < r ? xcd * (q + 1) : r * (q + 1) + (xcd - r) * q) + off; }
        const int nig = WGM * nN, gid = wgid / nig, fm = gid * WGM, gsz = (nM - fm) < WGM ? (nM - fm) : WGM;
        u.pm = fm + ((wgid % nig) % gsz); u.pn = (wgid % nig) / gsz; return true;
    }
    __device__ __forceinline__ void a_ready(const Unit&) const {}
    __device__ __forceinline__ void done(const Unit&) const {}
};

__device__ __forceinline__ unsigned cvt_pk_bf16(float lo, float hi) { unsigned r; asm volatile("v_cvt_pk_bf16_f32 %0, %1, %2" : "=v"(r) : "v"(lo), "v"(hi)); return r; }
typedef float f32x2 __attribute__((ext_vector_type(2)));
typedef float f32x4g __attribute__((ext_vector_type(4)));
__device__ __forceinline__ float silu_f(float x) { return x / (1.f + __expf(-x)); }
struct EpiH {
    static constexpr bool PERM = true, AFTER_DRAIN = false;
    bf16_t* H; float* out; const float* rope;
    __device__ __forceinline__ void operator()(const f32x4 (&acc)[2][2][4][2], const Unit& u, int wr, int wc, int fr, int fq) const {
        const int row0 = u.pm * BM + wr * 64 + fr;
        const int region = u.pn >> 1;
        constexpr int O_KP = 16809984, O_VP = 25198592, O_CP = 34111488;
        constexpr float QSC = 0.125f * 1.4426950408889634f;
#pragma unroll
        for (int ai = 0; ai < 2; ++ai)
#pragma unroll
            for (int m = 0; m < 4; ++m) {
                const int row = row0 + ai * HALF + m * 16; const int t = row & 2047;
#pragma unroll
                for (int bj = 0; bj < 2; ++bj) {
                    const int c0 = u.pn * BM + bj * HALF + wc * 32 + 8 * fq;
                    f32x4 v0 = acc[ai][bj][m][0], v1 = acc[ai][bj][m][1];
                    if (region <= 1) {
                        const int pos = c0 & 63, chunk = (c0 & 511) >> 6;
                        if (pos < 16) {
                            const int f0 = pos >> 1;
                            const f32x4 cs0 = *(const f32x4*)(rope + (size_t)t * 16 + f0 * 2), cs1 = *(const f32x4*)(rope + (size_t)t * 16 + f0 * 2 + 4);
                            f32x4 a, b;
                            a[0] = v0[0] * cs0[0] - v0[1] * cs0[1]; b[0] = v0[1] * cs0[0] + v0[0] * cs0[1];
                            a[1] = v0[2] * cs0[2] - v0[3] * cs0[3]; b[1] = v0[3] * cs0[2] + v0[2] * cs0[3];
                            a[2] = v1[0] * cs1[0] - v1[1] * cs1[1]; b[2] = v1[1] * cs1[0] + v1[0] * cs1[1];
                            a[3] = v1[2] * cs1[2] - v1[3] * cs1[3]; b[3] = v1[3] * cs1[2] + v1[2] * cs1[3];
                            if (region == 1) { float* kp = out + O_KP + (size_t)row * 512 + chunk * 64 + f0; *(f32x4*)kp = a; *(f32x4*)(kp + 8) = b; }
                            v0 = (f32x4){a[0], b[0], a[1], b[1]}; v1 = (f32x4){a[2], b[2], a[3], b[3]};
                        } else if (region == 1) { float* kp = out + O_KP + (size_t)row * 512 + chunk * 64 + pos; *(f32x4*)kp = v0; *(f32x4*)(kp + 4) = v1; }
                        if (region == 0) { v0 = v0 * QSC; v1 = v1 * QSC; }
                    } else if (region == 2) {
                        float* vp = out + O_VP + (size_t)row * 512 + (c0 - 1024); *(f32x4*)vp = v0; *(f32x4*)(vp + 4) = v1;
                    } else if (region == 3 || region == 7) {
#pragma unroll
                        for (int j = 0; j < 4; ++j) { v0[j] = silu_f(v0[j]); v1[j] = silu_f(v1[j]); }
                    } else {
                        if (t >= 2045) { float* cp = out + O_CP + (size_t)((row >> 11) * 3 + (t - 2045)) * 1536 + (c0 - 2048); *(f32x4*)cp = v0; *(f32x4*)(cp + 4) = v1; }
                    }
                    u32x4 w; w.x = cvt_pk_bf16(v0[0], v0[1]); w.y = cvt_pk_bf16(v0[2], v0[3]); w.z = cvt_pk_bf16(v1[0], v1[1]); w.w = cvt_pk_bf16(v1[2], v1[3]);
                    *(u32x4*)(H + (size_t)row * 4096 + c0) = w;
                }
            }
    }
};
struct EpiF32 {
    static constexpr bool PERM = false, AFTER_DRAIN = false;
    float* C; int ldc;
    __device__ __forceinline__ void operator()(const f32x4 (&acc)[2][2][4][2], const Unit& u, int wr, int wc, int fr, int fq) const {
        const int row0 = u.pm * BM + wr * 64 + fr, col0 = u.pn * BM + wc * 32 + 4 * fq;
#pragma unroll
        for (int ai = 0; ai < 2; ++ai)
#pragma unroll
            for (int m = 0; m < 4; ++m) { float* rowp = C + (size_t)(row0 + ai * HALF + m * 16) * ldc + col0;
#pragma unroll
                for (int bj = 0; bj < 2; ++bj)
#pragma unroll
                    for (int n = 0; n < 2; ++n) *(f32x4*)(rowp + bj * HALF + n * 16) = acc[ai][bj][m][n]; }
    }
};
template <class Epi, class Sched, bool ALIGN_EPI = false, bool SP2 = false>
__device__ __forceinline__ void gemm_phase(PG8_LAS unsigned char* lds, const Gemm g, const Sched& S, const Epi& E) {
    const int tid = threadIdx.x, wid = __builtin_amdgcn_readfirstlane(tid >> 6), lane = tid & 63, wr = wid >> 2, wc = wid & 3, fr = lane & 15, fq = lane >> 4;
    const int K = g.K, nt = K / BK;
    unsigned voffA[2], voffB[2];
#pragma unroll
    for (int i = 0; i < 2; ++i) { int R, C; stage_rc(tid * 16 + i * 8192, R, C); const int Rb = Epi::PERM ? ((R & ~31) + perm32(R & 31)) : R;
        voffA[i] = (unsigned)(R * K + C) * 2u; voffB[i] = (unsigned)(Rb * K + C) * 2u; }
    const size_t kstep = (size_t)(BK * 2);
    const size_t hstep = (size_t)HALF * K * 2;
    const size_t tstep = 2 * hstep;
    const unsigned ldsw = (unsigned)wid * 1024u;
    const int aoff = lds_byte(wr * 64 + fr, fq * 8), boff = lds_byte(wc * 32 + fr, fq * 8);
#define PG8_SA(b, h) (((b) * 2 + (h)) * HTB)
#define PG8_SB(b, h) ((4 + (b) * 2 + (h)) * HTB)
#define PG8_STAGE(bufoff, gbase, voff) do { _Pragma("unroll") for (int _i = 0; _i < 2; ++_i) \
        __builtin_amdgcn_global_load_lds((const unsigned*)((const char*)(gbase) + (voff)[_i]), (PG8_LAS unsigned*)(lds + (bufoff) + ldsw + _i * 8192), 16, 0, 0); } while (0)
#define PG8_LDA(dst, b, h) do { _Pragma("unroll") for (int m = 0; m < 4; ++m) _Pragma("unroll") for (int k = 0; k < 2; ++k) dst[m][k] = *(const PG8_LAS bf16x8*)(lds + PG8_SA(b, h) + aoff + m * 2048 + k * 1024); } while (0)
#define PG8_LDB(dst, b, h) do { _Pragma("unroll") for (int n = 0; n < 2; ++n) _Pragma("unroll") for (int k = 0; k < 2; ++k) dst[n][k] = *(const PG8_LAS bf16x8*)(lds + PG8_SB(b, h) + boff + n * 2048 + k * 1024); } while (0)
#define PG8_MMA(ai, bj, At, Bt) do { __builtin_amdgcn_s_setprio(1); _Pragma("unroll") for (int m = 0; m < 4; ++m) _Pragma("unroll") for (int n = 0; n < 2; ++n) _Pragma("unroll") for (int k = 0; k < 2; ++k) \
        acc[ai][bj][m][n] = __builtin_amdgcn_mfma_f32_16x16x32_bf16(Bt[n][k], At[m][k], acc[ai][bj][m][n], 0, 0, 0); __builtin_amdgcn_s_setprio(0); } while (0)
#define PG8_WAIT_V(n) asm volatile("s_waitcnt vmcnt(" #n ")" ::: "memory")
#define PG8_WAIT_L(n) asm volatile("s_waitcnt lgkmcnt(" #n ")" ::: "memory")
#define PG8_BAR __builtin_amdgcn_s_barrier()
#define PG8_SCHED __builtin_amdgcn_sched_barrier(0)
    Unit cur, nxt; int ui = 0;
    if (!S.next(0, cur)) return;
    f32x4 acc[2][2][4][2];
#pragma unroll
    for (int a = 0; a < 2; ++a)
#pragma unroll
        for (int b = 0; b < 2; ++b)
#pragma unroll
            for (int m = 0; m < 4; ++m)
#pragma unroll
                for (int n = 0; n < 2; ++n) acc[a][b][m][n] = (f32x4){0.f, 0.f, 0.f, 0.f};
    bf16x8 At[4][2], B0[2][2], B1[2][2];
    const char* cA = (const char*)g.A + (size_t)cur.pm * tstep; const char* cB = (const char*)g.Bt + (size_t)cur.pn * tstep;
    S.a_ready(cur);
    if constexpr (SP2) {
        PG8_STAGE(PG8_SB(0, 0), cB, voffB); PG8_STAGE(PG8_SB(0, 1), cB + hstep, voffB); PG8_STAGE(PG8_SA(0, 0), cA, voffA); PG8_STAGE(PG8_SA(0, 1), cA + hstep, voffA);
        if (wr == 1) PG8_BAR;
        PG8_WAIT_V(2); PG8_BAR;
        PG8_STAGE(PG8_SB(1, 0), cB + kstep, voffB); PG8_STAGE(PG8_SA(1, 0), cA + kstep, voffA); PG8_STAGE(PG8_SB(1, 1), cB + hstep + kstep, voffB);
        PG8_WAIT_V(6); PG8_BAR;
    } else {
        PG8_STAGE(PG8_SB(0, 0), cB, voffB); PG8_STAGE(PG8_SA(0, 0), cA, voffA); PG8_STAGE(PG8_SB(0, 1), cB + hstep, voffB); PG8_STAGE(PG8_SA(0, 1), cA + hstep, voffA);
        if (wr == 1) PG8_BAR;
        PG8_WAIT_V(4); PG8_BAR;
        PG8_STAGE(PG8_SB(1, 0), cB + kstep, voffB); PG8_STAGE(PG8_SA(1, 0), cA + kstep, voffA); PG8_STAGE(PG8_SB(1, 1), cB + hstep + kstep, voffB);
        PG8_WAIT_V(6); PG8_BAR;
    }
    for (;;) {
        const bool has_next = S.next(ui + 1, nxt);
        const char* nA = has_next ? (const char*)g.A + (size_t)nxt.pm * tstep : cA; const char* nB = has_next ? (const char*)g.Bt + (size_t)nxt.pn * tstep : cB;
        for (int t = 0; t < nt; t += 2) {
            const bool last = (t == nt - 2);
            const char* a1 = cA + (size_t)(t + 1) * kstep;
            const char* a2 = last ? nA : cA + (size_t)(t + 2) * kstep; const char* b2 = last ? nB : cB + (size_t)(t + 2) * kstep;
            const char* a3 = a2 + kstep; const char* b3 = b2 + kstep;
            if (last && has_next) S.a_ready(nxt);
            if constexpr (SP2) {
            PG8_LDB(B0, 0, 0); PG8_LDB(B1, 0, 1); PG8_SCHED; PG8_LDA(At, 0, 0); PG8_STAGE(PG8_SA(1, 1), a1 + hstep, voffA);
            PG8_WAIT_V(8); PG8_WAIT_L(0); PG8_BAR; PG8_MMA(0, 0, At, B0); PG8_MMA(0, 1, At, B1); PG8_BAR; PG8_SCHED;
            PG8_LDA(At, 0, 1); PG8_STAGE(PG8_SB(0, 0), b2, voffB); PG8_STAGE(PG8_SB(0, 1), b2 + hstep, voffB); PG8_STAGE(PG8_SA(0, 0), a2, voffA);
            PG8_WAIT_V(8); PG8_WAIT_L(0); PG8_BAR; PG8_MMA(1, 0, At, B0); PG8_MMA(1, 1, At, B1); PG8_BAR; PG8_SCHED;
            PG8_LDB(B0, 1, 0); PG8_LDB(B1, 1, 1); PG8_SCHED; PG8_LDA(At, 1, 0); PG8_STAGE(PG8_SA(0, 1), a2 + hstep, voffA);
            PG8_WAIT_V(8); PG8_WAIT_L(0); PG8_BAR; PG8_MMA(0, 0, At, B0); PG8_MMA(0, 1, At, B1); PG8_BAR; PG8_SCHED;
            PG8_LDA(At, 1, 1); PG8_STAGE(PG8_SB(1, 0), b3, voffB); PG8_STAGE(PG8_SB(1, 1), b3 + hstep, voffB); PG8_STAGE(PG8_SA(1, 0), a3, voffA);
            PG8_WAIT_V(8); PG8_WAIT_L(0); PG8_BAR; PG8_MMA(1, 0, At, B0); PG8_MMA(1, 1, At, B1); PG8_BAR; PG8_SCHED;
            } else {
            PG8_LDB(B0, 0, 0); PG8_SCHED; PG8_LDA(At, 0, 0); PG8_STAGE(PG8_SA(1, 1), a1 + hstep, voffA);
            PG8_WAIT_L(8); PG8_BAR; PG8_WAIT_L(0); PG8_MMA(0, 0, At, B0); PG8_BAR; PG8_SCHED;
            PG8_LDB(B1, 0, 1); PG8_STAGE(PG8_SB(0, 0), b2, voffB);
            PG8_BAR; PG8_WAIT_L(0); PG8_MMA(0, 1, At, B1); PG8_BAR;
            PG8_LDA(At, 0, 1); PG8_STAGE(PG8_SA(0, 0), a2, voffA);
            PG8_BAR; PG8_WAIT_L(0); PG8_MMA(1, 0, At, B0); PG8_BAR; PG8_SCHED;
            PG8_STAGE(PG8_SB(0, 1), b2 + hstep, voffB);
            PG8_WAIT_V(6); PG8_BAR; PG8_MMA(1, 1, At, B1); PG8_BAR;
            PG8_LDB(B0, 1, 0); PG8_SCHED; PG8_LDA(At, 1, 0); PG8_STAGE(PG8_SA(0, 1), a2 + hstep, voffA);
            PG8_WAIT_L(8); PG8_BAR; PG8_WAIT_L(0); PG8_MMA(0, 0, At, B0); PG8_BAR; PG8_SCHED;
            PG8_LDB(B1, 1, 1); PG8_STAGE(PG8_SB(1, 0), b3, voffB);
            PG8_BAR; PG8_WAIT_L(0); PG8_MMA(0, 1, At, B1); PG8_BAR;
            PG8_LDA(At, 1, 1); PG8_STAGE(PG8_SA(1, 0), a3, voffA);
            PG8_BAR; PG8_WAIT_L(0); PG8_MMA(1, 0, At, B0); PG8_BAR; PG8_SCHED;
            PG8_STAGE(PG8_SB(1, 1), b3 + hstep, voffB);
            PG8_WAIT_V(6); PG8_BAR; PG8_MMA(1, 1, At, B1); PG8_BAR;
            }
        }
        if constexpr (ALIGN_EPI) { if (wr == 0) PG8_BAR; }
        if constexpr (!Epi::AFTER_DRAIN) { E(acc, cur, wr, wc, fr, fq); S.done(cur); }
        if (!has_next) break;
#pragma unroll
        for (int a = 0; a < 2; ++a)
#pragma unroll
            for (int b = 0; b < 2; ++b)
#pragma unroll
                for (int m = 0; m < 4; ++m)
#pragma unroll
                    for (int n = 0; n < 2; ++n) acc[a][b][m][n] = (f32x4){0.f, 0.f, 0.f, 0.f};
        cur = nxt; cA = nA; cB = nB; ++ui;
        if constexpr (ALIGN_EPI) { if (wr == 1) PG8_BAR; }
    }
    PG8_WAIT_V(0);
    if constexpr (!ALIGN_EPI) { if (wr == 0) PG8_BAR; }
    PG8_BAR;
    if constexpr (Epi::AFTER_DRAIN) { E.fused(acc, cur, wr, wc, fr, fq, lds, wid, lane); S.done(cur); }
#undef PG8_SA
#undef PG8_SB
#undef PG8_STAGE
#undef PG8_LDA
#undef PG8_LDB
#undef PG8_MMA
#undef PG8_WAIT_V
#undef PG8_WAIT_L
#undef PG8_BAR
#undef PG8_SCHED
}
}
#define LAS __attribute__((address_space(3)))
using pg8::silu_f;
typedef unsigned short bf16_t;
typedef float f32x4 __attribute__((ext_vector_type(4)));
typedef float f32x2 __attribute__((ext_vector_type(2)));
typedef unsigned u32x4 __attribute__((ext_vector_type(4)));
typedef unsigned u32x2 __attribute__((ext_vector_type(2)));
constexpr int D = 1024, NB = 8, SEQ = 2048, MP = NB * SEQ, NS = 32, PIN = 4104, NH = 4096;
constexpr int NPAGES = 64, PAGE = 128;
constexpr int O_Y = 0, O_YS = 16777216, O_KP = 16809984, O_VP = 25198592, O_SP = 33587200, O_CP = 34111488, O_KS = 34148352, O_VS = 34164736, O_SS = 34181120, O_CS = 36278272, O_END = 36425728;
constexpr size_t MiB = 1u << 20;
constexpr size_t WS_CTL = 0, CTL_ZERO_BYTES = 1 * MiB;
constexpr size_t WS_WTIN = 1 * MiB, WS_WTOUT = 9 * MiB, WS_ROPE = 11 * MiB, WS_BETA = 12 * MiB, WS_G = 13 * MiB, WS_HSP = 14 * MiB  ;
constexpr size_t WS_QS = 20 * MiB  , WS_GSA = 21 * MiB  , WS_MIXS = 22 * MiB  ;
constexpr size_t WS_XB = 32 * MiB, WS_H = 64 * MiB, WS_OA = 192 * MiB, WS_OB = 224 * MiB, WS_MIXIN = 256 * MiB, WS_MIX = 296 * MiB, WS_PART = 368 * MiB, WS_END = 400 * MiB;
constexpr int CW_BAR = 4096;
constexpr int LDS_BYTES = 147456;
constexpr int MISC_OFF = 131072 + 320;
constexpr float LAM_INIT = 0.2f;

struct Params {
    const float *x_prompt, *x_sample, *cache_k, *cache_v; const int* page_table; const float *state_delta, *state_conv, *w_in, *conv_w, *a_log, *dt_bias, *delta_norm_w, *diff_lambda, *diff_norm_w, *w_out, *ln_g, *ln_b;
    float* out; unsigned char* ws; int ph_lo, ph_hi;
};
__device__ __forceinline__ float bf2f(bf16_t b) { return __uint_as_float(((unsigned)b) << 16); }
__device__ __forceinline__ unsigned f2bf(float f) { unsigned u = __float_as_uint(f); return (u + 0x7fffu + ((u >> 16) & 1u)) >> 16; }
__device__ __forceinline__ unsigned pk2(float lo, float hi) { return f2bf(lo) | (f2bf(hi) << 16); }
__device__ __forceinline__ float wave_sum(float v) {
#pragma unroll
    for (int o = 1; o < 64; o <<= 1) v += __shfl_xor(v, o);
    return v;
}
#define LDS_WAIT() asm volatile("s_waitcnt lgkmcnt(0)" ::: "memory")
#define XB_TMO      128
#define XB_XCNT(j)  (256  + 64 * (j))
#define XB_XSUB(j)  (1280 + 64 * (j))
#define XB_XGEN(j)  (2304 + 64 * (j))
#define XB_TOP      3328
#define XB_TOPGEN   3392
#define XCD_BAR_WORDS 3456
#define XB_SPIN_CAP (1u << 18)
__device__ __forceinline__ unsigned xb_ld(unsigned* p)              { return __hip_atomic_load(p, __ATOMIC_RELAXED, __HIP_MEMORY_SCOPE_AGENT); }
__device__ __forceinline__ unsigned xb_add(unsigned* p, unsigned v) { return __hip_atomic_fetch_add(p, v, __ATOMIC_RELAXED, __HIP_MEMORY_SCOPE_AGENT); }
__device__ __forceinline__ unsigned xb_xcc_id() { return (unsigned)__builtin_amdgcn_s_getreg((3 << 11) | 20) & 0xFu; }
#define XB_SPIN(cond, bar) do { unsigned _sp = 0; while (cond) { __builtin_amdgcn_s_sleep(1); \
    if ((++_sp & 255u) == 0u) { if (xb_ld(&(bar)[XB_TMO])) break; if (_sp > XB_SPIN_CAP) { atomicAdd(&(bar)[XB_TMO], 1u); break; } } } } while (0)

struct XcdBarrier {
    unsigned* bar; unsigned x;
    volatile LAS unsigned* st;
};

__device__ __forceinline__ XcdBarrier xcd_barrier_post(unsigned* bar, volatile LAS unsigned* st) {
    XcdBarrier b; b.bar = bar; b.x = xb_xcc_id(); b.st = st;
    if (threadIdx.x == 0) (void)xb_add(&bar[XB_XCNT(b.x)], 1u);
    return b;
}
__device__ __forceinline__ void xcd_barrier_complete(unsigned* bar, unsigned x, unsigned& nloc, unsigned& nx) {
    const unsigned G = gridDim.x * gridDim.y * gridDim.z;
    unsigned sum, cnt, mine, sp = 0u;
    for (;;) {
        sum = 0u; cnt = 0u; mine = 0u;
#pragma unroll
        for (unsigned j = 0; j < 16; ++j) { const unsigned c = xb_ld(&bar[XB_XCNT(j)]); sum += c; cnt += (c > 0u) ? 1u : 0u; mine = (j == x) ? c : mine; }
        if (sum == G) break;
        __builtin_amdgcn_s_sleep(1);
        if ((++sp & 255u) == 0u) { if (xb_ld(&bar[XB_TMO])) break; if (sp > XB_SPIN_CAP) { atomicAdd(&bar[XB_TMO], 1u); break; } }
    }
    nloc = mine > 0u ? mine : 1u; nx = cnt > 0u ? cnt : 1u;
}

__device__ __forceinline__ void xcd_barrier(const XcdBarrier& b) {
    asm volatile("s_waitcnt vmcnt(0)" ::: "memory");
    __syncthreads();
    if (threadIdx.x == 0) {
        unsigned* bar = b.bar;
        __builtin_amdgcn_s_waitcnt(0);
        unsigned nloc = b.st[0], nx = b.st[1];
        if (nloc == 0u) { xcd_barrier_complete(bar, b.x, nloc, nx); b.st[0] = nloc; b.st[1] = nx; }
        const unsigned old = xb_add(&bar[XB_XSUB(b.x)], 1u);
        const unsigned gen = old / nloc;
        if (old + 1u == (gen + 1u) * nloc) {
            __builtin_amdgcn_fence(__ATOMIC_RELEASE, "agent");
            asm volatile("s_waitcnt vmcnt(0)" ::: "memory");
            const unsigned og = xb_add(&bar[XB_TOP], 1u);
            const unsigned tg = og / nx;
            if (og + 1u == (tg + 1u) * nx) xb_add(&bar[XB_TOPGEN], 1u);
            else XB_SPIN(xb_ld(&bar[XB_TOPGEN]) == tg, bar);
            __builtin_amdgcn_fence(__ATOMIC_ACQUIRE, "agent");
            xb_add(&bar[XB_XGEN(b.x)], 1u);
            asm volatile("s_waitcnt vmcnt(0)" ::: "memory");
        } else {
            XB_SPIN(xb_ld(&bar[XB_XGEN(b.x)]) == gen, bar);
            __builtin_amdgcn_fence(__ATOMIC_ACQUIRE, "agent");
            asm volatile("s_waitcnt vmcnt(0)" ::: "memory");
        }
    }
    __syncthreads();
}
__device__ __forceinline__ void p0_transpose_item(const float* W, int K, int ldw, int N, bf16_t* WT, LAS float* scr, int item, int lane, bool permq) {
    const int nblk = N / 32, kb = item / nblk, nb = item % nblk, k0 = 64 * kb, n0 = 32 * nb;
    int sc = lane & 31;
    if (permq && n0 < 1024 && (n0 & 32) == 0 && sc < 16) sc = (sc >> 1) + 8 * (sc & 1);
#pragma unroll 8
    for (int i = 0; i < 32; ++i) { const int kk = 2 * i + (lane >> 5); scr[kk * 33 + (lane & 31)] = W[(size_t)(k0 + kk) * ldw + n0 + sc]; }
    LDS_WAIT(); asm volatile("" ::: "memory");
    const int c = lane & 7;
#pragma unroll
    for (int j = 0; j < 4; ++j) { const int n = (lane >> 3) + 8 * j; const LAS float* s = scr + (8 * c) * 33 + n;
        u32x4 o; o.x = pk2(s[0 * 33], s[1 * 33]); o.y = pk2(s[2 * 33], s[3 * 33]); o.z = pk2(s[4 * 33], s[5 * 33]); o.w = pk2(s[6 * 33], s[7 * 33]);
        *(u32x4*)(WT + (size_t)(n0 + n) * K + k0 + 8 * c) = o; }
    LDS_WAIT(); asm volatile("" ::: "memory");
}
__device__ __forceinline__ void ph_prologue(const Params& p, LAS unsigned char* lds, int bid, int nblk) {
    const int tid = threadIdx.x, lane = tid & 63, wave = tid >> 6;
    const int gw = bid * 8 + wave, ngw = nblk * 8;
    bf16_t* WTI = (bf16_t*)(p.ws + WS_WTIN); bf16_t* WTO = (bf16_t*)(p.ws + WS_WTOUT);
    { LAS float* scr = (LAS float*)(lds + wave * 8704);
      constexpr int I_IN = 16 * 128, I_OUT = 16 * 32;
      for (int it = gw; it < I_IN + I_OUT; it += ngw) {
          if (it < I_IN) p0_transpose_item(p.w_in, 1024, PIN, 4096, WTI, scr, it, lane, true);
          else p0_transpose_item(p.w_out, 1024, 1024, 1024, WTO, scr, it - I_IN, lane, false);
      } }
    LAS float* wb = (LAS float*)(lds + 69632);
    for (int i = tid; i < 8192; i += 512) wb[i] = p.w_in[(size_t)(i >> 3) * PIN + 4096 + (i & 7)];
    __syncthreads();
    { bf16_t* XB = (bf16_t*)(p.ws + WS_XB); float* BETA = (float*)(p.ws + WS_BETA); float* GG = (float*)(p.ws + WS_G);
      for (int row = gw; row < MP + NS; row += ngw) {
          const float* src = row < MP ? p.x_prompt + (size_t)row * D : p.x_sample + (size_t)(row - MP) * D;
          f32x4 v[4]; float acc[8];
#pragma unroll
          for (int c = 0; c < 8; ++c) acc[c] = 0.f;
#pragma unroll
          for (int j = 0; j < 4; ++j) v[j] = *(const f32x4*)(src + 4 * lane + 256 * j);
          if (row < MP) {
#pragma unroll
              for (int j = 0; j < 4; ++j) { u32x2 w; w.x = pk2(v[j][0], v[j][1]); w.y = pk2(v[j][2], v[j][3]); *(u32x2*)(XB + (size_t)row * D + 4 * lane + 256 * j) = w; } }
#pragma unroll
          for (int j = 0; j < 4; ++j)
#pragma unroll
              for (int e = 0; e < 4; ++e) { const int k = 256 * j + 4 * lane + e; const f32x4 w0 = *(const LAS f32x4*)(wb + k * 8), w1 = *(const LAS f32x4*)(wb + k * 8 + 4); const float xv = v[j][e];
                  acc[0] += xv * w0[0]; acc[1] += xv * w0[1]; acc[2] += xv * w0[2]; acc[3] += xv * w0[3]; acc[4] += xv * w1[0]; acc[5] += xv * w1[1]; acc[6] += xv * w1[2]; acc[7] += xv * w1[3]; }
#pragma unroll
          for (int c = 0; c < 8; ++c) acc[c] = wave_sum(acc[c]);
          float s = acc[0];
#pragma unroll
          for (int c = 1; c < 8; ++c) s = (lane == c) ? acc[c] : s;
          if (lane < 4) BETA[(size_t)row * 4 + lane] = 1.f / (1.f + expf(-s));
          else if (lane < 8) { const int h = lane - 4; const float xx = s + p.dt_bias[h]; const float sp = xx > 20.f ? xx : log1pf(expf(xx)); GG[(size_t)row * 4 + h] = -expf(p.a_log[h]) * sp; }
      } }
    { float* RT = (float*)(p.ws + WS_ROPE);
      for (int i = bid * 512 + tid; i < 2049 * 8; i += nblk * 512) { const int pi = i >> 3, f = i & 7; const float pos = pi < 2048 ? (float)pi : 8192.f;
          const float inv = (float)pow(500000.0, -(double)f / 8.0); const float ang = pos * inv; RT[2 * i] = (float)cos((double)ang); RT[2 * i + 1] = (float)sin((double)ang); } }
    { float* HSP = (float*)(p.ws + WS_HSP); LAS float* xs = (LAS float*)(lds + 102400);
      for (int item = bid; item < 72; item += nblk) { const int ks = item / 9, cb = item % 9, col = cb * 512 + tid;
          __syncthreads();
          for (int i = tid; i < 4096; i += 512) xs[i] = p.x_sample[(size_t)(i >> 7) * D + ks * 128 + (i & 127)];
          __syncthreads();
          if (col < PIN) { float acc[32];
#pragma unroll
              for (int r = 0; r < 32; ++r) acc[r] = 0.f;
              for (int kk = 0; kk < 128; kk += 4) { const float* wp = p.w_in + (size_t)(ks * 128 + kk) * PIN + col; const float w0 = wp[0], w1 = wp[PIN], w2 = wp[2 * PIN], w3 = wp[3 * PIN];
#pragma unroll
                  for (int r = 0; r < 32; ++r) { const f32x4 x4 = *(const LAS f32x4*)(xs + r * 128 + kk); acc[r] += x4[0] * w0 + x4[1] * w1 + x4[2] * w2 + x4[3] * w3; } }
#pragma unroll
              for (int r = 0; r < 32; ++r) HSP[(size_t)(ks * 32 + r) * PIN + col] = acc[r]; }
      } }
}
__device__ __forceinline__ void ph_sample_post(const Params& p, LAS unsigned char* lds, int bid, int nblk) {
    const int tid = threadIdx.x, t = tid & 127, cat = tid >> 7;
    LAS float* raw = (LAS float*)lds;
    LAS float* cv3 = raw + 1024;
    LAS float* gzb = cv3 + 384;
    LAS float* red = gzb + 128;
    LAS float* red2 = red + 512;
    LAS float* ov = red2 + 512;
    const float* HSP = (const float*)(p.ws + WS_HSP); const float* RT = (const float*)(p.ws + WS_ROPE) + 2048 * 16;
    float* QS = (float*)(p.ws + WS_QS); float* GSA = (float*)(p.ws + WS_GSA);
    const float* BETA = (const float*)(p.ws + WS_BETA); const float* GG = (const float*)(p.ws + WS_G);
    bf16_t* MIXIN = (bf16_t*)(p.ws + WS_MIXIN);
    for (int u = bid; u < NS * 4; u += nblk) {
        const int b = u >> 2, h = u & 3;
        __syncthreads();
        { const int col1 = cat * 512 + h * 128 + t, col2 = (cat + 4) * 512 + h * 128 + t; float s1 = 0.f, s2 = 0.f;
          for (int ks = 0; ks < 8; ++ks) { s1 += HSP[(size_t)(ks * 32 + b) * PIN + col1]; s2 += HSP[(size_t)(ks * 32 + b) * PIN + col2]; }
          raw[cat * 128 + t] = s1; raw[(cat + 4) * 128 + t] = s2; }
        __syncthreads();
        {
            const float x = raw[cat * 128 + t]; const int d = t & 63;
            if (cat <= 1) { float o = x;
                if (d < 8) { const float x2 = raw[cat * 128 + t + 8]; o = x * RT[2 * d] - x2 * RT[2 * d + 1]; }
                else if (d < 16) { const float x1 = raw[cat * 128 + t - 8]; const int f = d - 8; o = x * RT[2 * f] + x1 * RT[2 * f + 1]; }
                if (cat == 0) QS[b * 512 + h * 128 + t] = o * 0.125f; else p.out[O_KS + b * 512 + h * 128 + t] = o; }
            else if (cat == 2) p.out[O_VS + b * 512 + h * 128 + t] = x;
            else GSA[b * 512 + h * 128 + t] = silu_f(x);
            const float y = raw[(cat + 4) * 128 + t];
            if (cat < 3) { const int ch = cat * 512 + h * 128 + t; const float* sc = p.state_conv + (size_t)b * 3 * 1536 + ch;
                const float s0 = sc[0], s1 = sc[1536], s2 = sc[3072];
                const float val = s0 * p.conv_w[ch] + s1 * p.conv_w[1536 + ch] + s2 * p.conv_w[3072 + ch] + y * p.conv_w[4608 + ch];
                cv3[cat * 128 + t] = silu_f(val);
                float* co = p.out + O_CS + (size_t)b * 3 * 1536 + ch; co[0] = s1; co[1536] = s2; co[3072] = y; }
            else gzb[t] = silu_f(y);
        }
        __syncthreads();
        float sq = 0.f, sk = 0.f;
        for (int i = 0; i < 128; ++i) { const float a = cv3[i], c = cv3[128 + i]; sq += a * a; sk += c * c; }
        const float nq = rsqrtf(sq + 1e-6f) * 0.08838834764831845f, nk = rsqrtf(sk + 1e-6f);
        const float beta = BETA[(size_t)(MP + b) * 4 + h], eg = expf(GG[(size_t)(MP + b) * 4 + h]);
        const int dv = t, g4 = cat;
        float S[32]; const float* S0 = p.state_delta + ((size_t)(b * 4 + h) * 128 + g4 * 32) * 128 + dv;
        float part = 0.f;
#pragma unroll
        for (int i = 0; i < 32; ++i) { S[i] = S0[(size_t)i * 128]; part += S[i] * cv3[128 + g4 * 32 + i]; }
        red[g4 * 128 + dv] = part;
        __syncthreads();
        const float r = (red[dv] + red[128 + dv] + red[256 + dv] + red[384 + dv]) * nk;
        const float vnew = beta * (cv3[256 + dv] - eg * r);
        float part2 = 0.f; float* S1 = p.out + O_SS + ((size_t)(b * 4 + h) * 128 + g4 * 32) * 128 + dv;
#pragma unroll
        for (int i = 0; i < 32; ++i) { S[i] = eg * S[i] + (cv3[128 + g4 * 32 + i] * nk) * vnew; S1[(size_t)i * 128] = S[i]; part2 += S[i] * cv3[g4 * 32 + i]; }
        red2[g4 * 128 + dv] = part2;
        __syncthreads();
        const float o = (red2[dv] + red2[128 + dv] + red2[256 + dv] + red2[384 + dv]) * nq;
        if (g4 == 0) ov[dv] = o;
        __syncthreads();
        if (g4 == 0) { float ss = 0.f; for (int i = 0; i < 128; ++i) ss += ov[i] * ov[i];
            const float rn = rsqrtf(ss * (1.f / 128.f) + 1e-6f);
            MIXIN[(size_t)(MP + b) * D + 512 + h * 128 + dv] = (bf16_t)f2bf(o * rn * p.delta_norm_w[dv] * gzb[dv]); }
    }
}
__device__ __forceinline__ void ph_attn_naive(const Params& p, LAS unsigned char* lds, int bid, int nblk) {
    const int tid = threadIdx.x, q = tid >> 3, kg = tid & 7;
    LAS float* Qs = (LAS float*)lds;
    LAS float* Ks = Qs + 4096;
    LAS float* Vs = Ks + 64 * 65;
    LAS float* Ps = Vs + 8192;
    const bf16_t* H = (const bf16_t*)(p.ws + WS_H); bf16_t* OA = (bf16_t*)(p.ws + WS_OA);
    for (int u = bid; u < 2048; u += nblk) {
        const int qt = 31 - (u >> 6), bc = u & 63, b = bc >> 3, c = bc & 7, h = c >> 1;
        const size_t rowb = (size_t)b * SEQ;
        __syncthreads();
        for (int i = tid; i < 4096; i += 512) { const int r = i >> 6, d = i & 63; Qs[i] = bf2f(H[(rowb + qt * 64 + r) * 4096 + c * 64 + d]); }
        float mrun = -INFINITY, lrun = 0.f, o[16];
#pragma unroll
        for (int j = 0; j < 16; ++j) o[j] = 0.f;
        for (int kt = 0; kt <= qt; ++kt) {
            __syncthreads();
            for (int i = tid; i < 4096; i += 512) { const int r = i >> 6, d = i & 63; Ks[r * 65 + d] = bf2f(H[(rowb + kt * 64 + r) * 4096 + 512 + c * 64 + d]); }
            for (int i = tid; i < 8192; i += 512) { const int r = i >> 7, d = i & 127; Vs[i] = bf2f(H[(rowb + kt * 64 + r) * 4096 + 1024 + h * 128 + d]); }
            __syncthreads();
            float s[8];
#pragma unroll
            for (int i = 0; i < 8; ++i) s[i] = 0.f;
            for (int d = 0; d < 64; ++d) { const float qv = Qs[q * 64 + d];
#pragma unroll
                for (int i = 0; i < 8; ++i) s[i] += qv * Ks[(kg + 8 * i) * 65 + d]; }
            float tmax = -INFINITY;
#pragma unroll
            for (int i = 0; i < 8; ++i) { if (kt == qt && (kg + 8 * i) > q) s[i] = -INFINITY; tmax = fmaxf(tmax, s[i]); }
            tmax = fmaxf(tmax, __shfl_xor(tmax, 1)); tmax = fmaxf(tmax, __shfl_xor(tmax, 2)); tmax = fmaxf(tmax, __shfl_xor(tmax, 4));
            const float mnew = fmaxf(mrun, tmax), alpha = exp2f(mrun - mnew);
            float psum = 0.f;
#pragma unroll
            for (int i = 0; i < 8; ++i) { const float pv = exp2f(s[i] - mnew); psum += pv; Ps[q * 65 + kg + 8 * i] = pv; }
            psum += __shfl_xor(psum, 1); psum += __shfl_xor(psum, 2); psum += __shfl_xor(psum, 4);
            lrun = lrun * alpha + psum; mrun = mnew;
#pragma unroll
            for (int j = 0; j < 16; ++j) o[j] *= alpha;
            __syncthreads();
            for (int k = 0; k < 64; ++k) { const float pk = Ps[q * 65 + k];
#pragma unroll
                for (int j = 0; j < 16; ++j) o[j] += pk * Vs[k * 128 + kg * 16 + j]; }
        }
        const float il = 1.f / lrun; bf16_t* op = OA + (rowb + qt * 64 + q) * 1024 + c * 128 + kg * 16;
#pragma unroll
        for (int j = 0; j < 16; j += 2) *(unsigned*)(op + j) = pk2(o[j] * il, o[j + 1] * il);
    }
}
__device__ __forceinline__ void ph_delta_naive(const Params& p, LAS unsigned char* lds, int bid, int nblk) {
    const int tid = threadIdx.x, lane = tid & 63, wave = tid >> 6, dv = tid & 127, g4 = tid >> 7;
    LAS float* cq = (LAS float*)lds;  LAS float* ck = cq + 128; LAS float* cvv = ck + 128;
    LAS float* wsum = cvv + 128;
    LAS float* red = wsum + 8;
    LAS float* red2 = red + 512;
    const bf16_t* H = (const bf16_t*)(p.ws + WS_H); float* OB = (float*)(p.ws + WS_OB);
    const float* BETA = (const float*)(p.ws + WS_BETA); const float* GG = (const float*)(p.ws + WS_G);
    for (int u = bid; u < 32; u += nblk) {
        const int b = u >> 2, h = u & 3; const size_t rowb = (size_t)b * SEQ;
        const int which = g4, col = 2048 + which * 512 + h * 128 + dv;
        float cw0 = 0.f, cw1 = 0.f, cw2 = 0.f, cw3 = 0.f;
        if (which < 3) { const int ch = col - 2048; cw0 = p.conv_w[ch]; cw1 = p.conv_w[1536 + ch]; cw2 = p.conv_w[3072 + ch]; cw3 = p.conv_w[4608 + ch]; }
        float x0 = 0.f, x1 = 0.f, x2 = 0.f;
        float S[32];
#pragma unroll
        for (int i = 0; i < 32; ++i) S[i] = 0.f;
        float xn = (which < 3) ? bf2f(H[rowb * 4096 + col]) : 0.f;
        __syncthreads();
        for (int t = 0; t < SEQ; ++t) {
            const size_t row = rowb + t;
            const float x3 = xn;
            if (which < 3 && t + 1 < SEQ) xn = bf2f(H[(row + 1) * 4096 + col]);
            const float beta = BETA[row * 4 + h], eg = expf(GG[row * 4 + h]);
            float val = 0.f;
            if (which < 3) { val = silu_f(x0 * cw0 + x1 * cw1 + x2 * cw2 + x3 * cw3); x0 = x1; x1 = x2; x2 = x3; }
            float sq = (which < 2) ? val * val : 0.f; sq = wave_sum(sq);
            if (lane == 0) wsum[wave] = sq;
            if (which == 0) cq[dv] = val; else if (which == 1) ck[dv] = val; else if (which == 2) cvv[dv] = val;
            __syncthreads();
            const float nq = rsqrtf(wsum[0] + wsum[1] + 1e-6f) * 0.08838834764831845f, nk = rsqrtf(wsum[2] + wsum[3] + 1e-6f);
            float part = 0.f;
#pragma unroll
            for (int i = 0; i < 32; ++i) part += S[i] * ck[g4 * 32 + i];
            red[g4 * 128 + dv] = part;
            __syncthreads();
            const float r = (red[dv] + red[128 + dv] + red[256 + dv] + red[384 + dv]) * nk;
            const float vnew = beta * (cvv[dv] - eg * r);
            float part2 = 0.f;
#pragma unroll
            for (int i = 0; i < 32; ++i) { S[i] = eg * S[i] + (ck[g4 * 32 + i] * nk) * vnew; part2 += S[i] * cq[g4 * 32 + i]; }
            red2[g4 * 128 + dv] = part2;
            __syncthreads();
            if (g4 == 0) OB[row * 512 + h * 128 + dv] = (red2[dv] + red2[128 + dv] + red2[256 + dv] + red2[384 + dv]) * nq;
        }
        float* SP = p.out + O_SP + ((size_t)(b * 4 + h) * 128 + g4 * 32) * 128 + dv;
#pragma unroll
        for (int i = 0; i < 32; ++i) SP[(size_t)i * 128] = S[i];
        __syncthreads();
    }
}
__device__ __forceinline__ void ph_decode(const Params& p, LAS unsigned char* lds, int bid, int nblk) {
    const int tid = threadIdx.x, lane = tid & 63, wave = tid >> 6;
    LAS float* sc = (LAS float*)(lds + wave * 4096);
    const float* QS = (const float*)(p.ws + WS_QS); float* PART = (float*)(p.ws + WS_PART);
    for (int wu = bid * 8 + wave; wu < NS * NPAGES; wu += nblk * 8) {
        const int b = wu >> 6;
        const int phys = p.page_table[wu];
        const float* kb = p.cache_k + (size_t)phys * (PAGE * 512); const float* vb = p.cache_v + (size_t)phys * (PAGE * 512);
        const f32x4 q0 = *(const f32x4*)(QS + b * 512 + 4 * lane), q1 = *(const f32x4*)(QS + b * 512 + 256 + 4 * lane);
        for (int t0 = 0; t0 < PAGE; t0 += 8) {
            f32x4 k0[8], k1[8];
#pragma unroll
            for (int i = 0; i < 8; ++i) { k0[i] = __builtin_nontemporal_load((const f32x4*)(kb + (size_t)(t0 + i) * 512 + 4 * lane)); k1[i] = __builtin_nontemporal_load((const f32x4*)(kb + (size_t)(t0 + i) * 512 + 256 + 4 * lane)); }
#pragma unroll
            for (int i = 0; i < 8; ++i) {
                float d0 = k0[i][0] * q0[0] + k0[i][1] * q0[1] + k0[i][2] * q0[2] + k0[i][3] * q0[3];
                float d1 = k1[i][0] * q1[0] + k1[i][1] * q1[1] + k1[i][2] * q1[2] + k1[i][3] * q1[3];
                d0 += __shfl_xor(d0, 8); d1 += __shfl_xor(d1, 8); d0 += __shfl_xor(d0, 4); d1 += __shfl_xor(d1, 4);
                d0 += __shfl_xor(d0, 2); d1 += __shfl_xor(d1, 2); d0 += __shfl_xor(d0, 1); d1 += __shfl_xor(d1, 1);
                if ((lane & 15) == 0) { sc[(t0 + i) * 8 + (lane >> 4)] = d0; sc[(t0 + i) * 8 + 4 + (lane >> 4)] = d1; }
            }
        }
        LDS_WAIT();
        const int c = lane & 7; float mx = -INFINITY, sv[16];
#pragma unroll
        for (int i = 0; i < 16; ++i) { sv[i] = sc[((lane >> 3) + 8 * i) * 8 + c]; mx = fmaxf(mx, sv[i]); }
        mx = fmaxf(mx, __shfl_xor(mx, 8)); mx = fmaxf(mx, __shfl_xor(mx, 16)); mx = fmaxf(mx, __shfl_xor(mx, 32));
        float ls = 0.f;
#pragma unroll
        for (int i = 0; i < 16; ++i) { const float e = __expf(sv[i] - mx); ls += e; sc[((lane >> 3) + 8 * i) * 8 + c] = e; }
        ls += __shfl_xor(ls, 8); ls += __shfl_xor(ls, 16); ls += __shfl_xor(ls, 32);
        LDS_WAIT();
        const int h0 = lane >> 5, h1 = 2 + (lane >> 5);
        f32x4 o00 = {0.f, 0.f, 0.f, 0.f}, o01 = o00, o10 = o00, o11 = o00;
        for (int t0 = 0; t0 < PAGE; t0 += 8) {
            f32x4 v0[8], v1[8];
#pragma unroll
            for (int i = 0; i < 8; ++i) { v0[i] = __builtin_nontemporal_load((const f32x4*)(vb + (size_t)(t0 + i) * 512 + 4 * lane)); v1[i] = __builtin_nontemporal_load((const f32x4*)(vb + (size_t)(t0 + i) * 512 + 256 + 4 * lane)); }
#pragma unroll
            for (int i = 0; i < 8; ++i) { const f32x2 pa = *(const LAS f32x2*)(sc + (t0 + i) * 8 + 2 * h0), pb = *(const LAS f32x2*)(sc + (t0 + i) * 8 + 2 * h1);
                o00 += v0[i] * pa[0]; o01 += v0[i] * pa[1]; o10 += v1[i] * pb[0]; o11 += v1[i] * pb[1]; }
        }
        float* pp = PART + (size_t)wu * 8 * 132;
        *(f32x4*)(pp + (2 * h0) * 132 + 4 * (lane & 31)) = o00; *(f32x4*)(pp + (2 * h0 + 1) * 132 + 4 * (lane & 31)) = o01;
        *(f32x4*)(pp + (2 * h1) * 132 + 4 * (lane & 31)) = o10; *(f32x4*)(pp + (2 * h1 + 1) * 132 + 4 * (lane & 31)) = o11;
        if (lane < 8) { pp[lane * 132 + 128] = mx; pp[lane * 132 + 129] = ls; }
        LDS_WAIT();
    }
}
__device__ __forceinline__ float lambda_of(const Params& p, int lane) {
    const float a = wave_sum(p.diff_lambda[lane] * p.diff_lambda[64 + lane]), b = wave_sum(p.diff_lambda[128 + lane] * p.diff_lambda[192 + lane]);
    return expf(a) - expf(b) + LAM_INIT;
}
__device__ __forceinline__ void ph_gate(const Params& p, LAS unsigned char* lds, int bid, int nblk) {
    const int tid = threadIdx.x, lane = tid & 63, wave = tid >> 6; const int gw = bid * 8 + wave, ngw = nblk * 8;
    const float lam = lambda_of(p, lane);
    const bf16_t* H = (const bf16_t*)(p.ws + WS_H); const bf16_t* OA = (const bf16_t*)(p.ws + WS_OA); const float* OB = (const float*)(p.ws + WS_OB);
    bf16_t* MIXIN = (bf16_t*)(p.ws + WS_MIXIN);
    const float nwa0 = p.diff_norm_w[2 * lane], nwa1 = p.diff_norm_w[2 * lane + 1], nwb0 = p.delta_norm_w[2 * lane], nwb1 = p.delta_norm_w[2 * lane + 1];
    for (int it = gw; it < MP * 4; it += ngw) {
        const int row = it >> 2, h = it & 3;
        const unsigned a0 = *(const unsigned*)(OA + (size_t)row * 1024 + (2 * h) * 128 + 2 * lane), a1 = *(const unsigned*)(OA + (size_t)row * 1024 + (2 * h + 1) * 128 + 2 * lane);
        const unsigned ga = *(const unsigned*)(H + (size_t)row * 4096 + 1536 + h * 128 + 2 * lane), gb = *(const unsigned*)(H + (size_t)row * 4096 + 3584 + h * 128 + 2 * lane);
        const f32x2 ob = *(const f32x2*)(OB + (size_t)row * 512 + h * 128 + 2 * lane);
        const float d0 = bf2f((bf16_t)(a0 & 0xffff)) - lam * bf2f((bf16_t)(a1 & 0xffff)), d1 = bf2f((bf16_t)(a0 >> 16)) - lam * bf2f((bf16_t)(a1 >> 16));
        const float ra = rsqrtf(wave_sum(d0 * d0 + d1 * d1) * (1.f / 128.f) + 1e-5f) * (1.f - LAM_INIT);
        const float rb = rsqrtf(wave_sum(ob[0] * ob[0] + ob[1] * ob[1]) * (1.f / 128.f) + 1e-6f);
        *(unsigned*)(MIXIN + (size_t)row * D + h * 128 + 2 * lane) = pk2(d0 * ra * nwa0 * bf2f((bf16_t)(ga & 0xffff)), d1 * ra * nwa1 * bf2f((bf16_t)(ga >> 16)));
        *(unsigned*)(MIXIN + (size_t)row * D + 512 + h * 128 + 2 * lane) = pk2(ob[0] * rb * nwb0 * bf2f((bf16_t)(gb & 0xffff)), ob[1] * rb * nwb1 * bf2f((bf16_t)(gb >> 16)));
    }
    const float* QS = (const float*)(p.ws + WS_QS); const float* GSA = (const float*)(p.ws + WS_GSA); const float* PART = (const float*)(p.ws + WS_PART);
    for (int it = gw; it < NS * 4; it += ngw) {
        const int b = it >> 2, h = it & 3; float om[2][2];
#pragma unroll
        for (int m = 0; m < 2; ++m) {
            const int c = 2 * h + m;
            const float sself = wave_sum(QS[b * 512 + c * 64 + lane] * p.out[O_KS + b * 512 + c * 64 + lane]);
            float M = sself;
            for (int pg = 0; pg < NPAGES; ++pg) M = fmaxf(M, PART[((size_t)(b * 64 + pg) * 8 + c) * 132 + 128]);
            const float ws = __expf(sself - M); float L = ws;
            float o0 = ws * p.out[O_VS + b * 512 + h * 128 + 2 * lane], o1 = ws * p.out[O_VS + b * 512 + h * 128 + 2 * lane + 1];
            for (int pg = 0; pg < NPAGES; ++pg) { const float* pp = PART + ((size_t)(b * 64 + pg) * 8 + c) * 132; const float w = __expf(pp[128] - M); L += w * pp[129];
                const f32x2 ov = *(const f32x2*)(pp + 2 * lane); o0 += w * ov[0]; o1 += w * ov[1]; }
            om[m][0] = o0 / L; om[m][1] = o1 / L;
        }
        const float d0 = om[0][0] - lam * om[1][0], d1 = om[0][1] - lam * om[1][1];
        const float ra = rsqrtf(wave_sum(d0 * d0 + d1 * d1) * (1.f / 128.f) + 1e-5f) * (1.f - LAM_INIT);
        *(unsigned*)(MIXIN + (size_t)(MP + b) * D + h * 128 + 2 * lane) = pk2(d0 * ra * nwa0 * GSA[b * 512 + h * 128 + 2 * lane], d1 * ra * nwa1 * GSA[b * 512 + h * 128 + 2 * lane + 1]);
    }
}
__device__ __forceinline__ void ph_sample_outproj(const Params& p, LAS unsigned char* lds, int bid, int nblk) {
    const int tid = threadIdx.x, col = tid & 127, kq = tid >> 7;
    LAS float* as = (LAS float*)lds;
    LAS float* red = as + 8192;
    const bf16_t* MIXIN = (const bf16_t*)(p.ws + WS_MIXIN); float* MIXS = (float*)(p.ws + WS_MIXS);
    for (int u = bid; u < 32; u += nblk) {
        const int rg = u >> 3, cb = u & 7;
        __syncthreads();
        for (int i = tid; i < 8192; i += 512) as[i] = bf2f(MIXIN[(size_t)(MP + rg * 8 + (i >> 10)) * D + (i & 1023)]);
        __syncthreads();
        float acc[8];
#pragma unroll
        for (int r = 0; r < 8; ++r) acc[r] = 0.f;
        for (int k = kq * 256; k < kq * 256 + 256; ++k) { const float w = p.w_out[(size_t)k * D + cb * 128 + col];
#pragma unroll
            for (int r = 0; r < 8; ++r) acc[r] += as[r * 1024 + k] * w; }
#pragma unroll
        for (int r = 0; r < 8; ++r) red[(kq * 8 + r) * 128 + col] = acc[r];
        __syncthreads();
        for (int i = tid; i < 1024; i += 512) { const int r = i >> 7, cc = i & 127;
            MIXS[(size_t)(rg * 8 + r) * D + cb * 128 + cc] = red[(0 * 8 + r) * 128 + cc] + red[(1 * 8 + r) * 128 + cc] + red[(2 * 8 + r) * 128 + cc] + red[(3 * 8 + r) * 128 + cc]; }
    }
}
__device__ __forceinline__ void ph_ln(const Params& p, int bid, int nblk) {
    const int tid = threadIdx.x, lane = tid & 63, wave = tid >> 6; const int gw = bid * 8 + wave, ngw = nblk * 8;
    const float* MIX = (const float*)(p.ws + WS_MIX); const float* MIXS = (const float*)(p.ws + WS_MIXS);
    const float alpha = 1.189207115002721f;
    for (int row = gw; row < MP + NS; row += ngw) {
        const float* xr = row < MP ? p.x_prompt + (size_t)row * D : p.x_sample + (size_t)(row - MP) * D;
        const float* mr = row < MP ? MIX + (size_t)row * D : MIXS + (size_t)(row - MP) * D;
        float* orow = row < MP ? p.out + O_Y + (size_t)row * D : p.out + O_YS + (size_t)(row - MP) * D;
        f32x4 v[4]; float s = 0.f;
#pragma unroll
        for (int j = 0; j < 4; ++j) { const f32x4 xv = *(const f32x4*)(xr + 4 * lane + 256 * j), mv = *(const f32x4*)(mr + 4 * lane + 256 * j); v[j] = xv * alpha + mv; s += (v[j][0] + v[j][1]) + (v[j][2] + v[j][3]); }
        const float mean = wave_sum(s) * (1.f / D); float s2 = 0.f;
#pragma unroll
        for (int j = 0; j < 4; ++j) { v[j] = v[j] - mean; s2 += (v[j][0] * v[j][0] + v[j][1] * v[j][1]) + (v[j][2] * v[j][2] + v[j][3] * v[j][3]); }
        const float rstd = rsqrtf(wave_sum(s2) * (1.f / D) + 1e-5f);
#pragma unroll
        for (int j = 0; j < 4; ++j) { const f32x4 gv = *(const f32x4*)(p.ln_g + 4 * lane + 256 * j), bv = *(const f32x4*)(p.ln_b + 4 * lane + 256 * j); *(f32x4*)(orow + 4 * lane + 256 * j) = v[j] * rstd * gv + bv; }
    }
}
#ifndef N_LAUNCHES
#define N_LAUNCHES 1
#endif
constexpr int N_PHASES = 10;
__global__ void __launch_bounds__(512, 2) fwd_kernel(Params p) {
    extern __shared__ __attribute__((aligned(16))) unsigned char lds_raw[];
    LAS unsigned char* lds = (LAS unsigned char*)lds_raw;
    const int tid = threadIdx.x, bid = blockIdx.x, nblk = gridDim.x;
    for (int u = tid; u < (LDS_BYTES - 131072) / 4; u += 512) ((LAS unsigned*)(lds + 131072))[u] = 0u;
    __syncthreads();
    XcdBarrier bar; bar.bar = (unsigned*)(p.ws + WS_CTL) + CW_BAR; bar.x = 0; bar.st = nullptr;
    if (N_LAUNCHES == 1) bar = xcd_barrier_post((unsigned*)(p.ws + WS_CTL) + CW_BAR, (volatile LAS unsigned*)(lds + MISC_OFF) + 8);
    const int lo = p.ph_lo, hi = p.ph_hi;
#define IN(k) (lo <= (k) && (k) < hi)
#define SEAM(k) do { if (IN(k) && IN((k) + 1)) { if (N_LAUNCHES == 1) xcd_barrier(bar); } else __syncthreads(); } while (0)
    if (IN(0)) ph_prologue(p, lds, bid, nblk);
    SEAM(0);
    if (IN(1)) {
        pg8::Gemm g{(const bf16_t*)(p.ws + WS_XB), (const bf16_t*)(p.ws + WS_WTIN), MP, NH, D}; pg8::StaticOrder S; S.init(MP, NH, nblk, bid);
        pg8::EpiH E{(bf16_t*)(p.ws + WS_H), p.out, (const float*)(p.ws + WS_ROPE)};
        pg8::gemm_phase<pg8::EpiH, pg8::StaticOrder, true, true>(lds, g, S, E);
    }
    __syncthreads();
    if (IN(2)) ph_sample_post(p, lds, bid, nblk);
    SEAM(2);
    if (IN(3)) ph_attn_naive(p, lds, bid, nblk);
    __syncthreads();
    if (IN(4)) ph_delta_naive(p, lds, bid, nblk);
    __syncthreads();
    if (IN(5)) ph_decode(p, lds, bid, nblk);
    SEAM(5);
    if (IN(6)) ph_gate(p, lds, bid, nblk);
    SEAM(6);
    if (IN(7)) {
        pg8::Gemm g{(const bf16_t*)(p.ws + WS_MIXIN), (const bf16_t*)(p.ws + WS_WTOUT), MP, D, D}; pg8::StaticOrder S; S.init(MP, D, nblk, bid);
        pg8::EpiF32 E{(float*)(p.ws + WS_MIX), D};
        pg8::gemm_phase<pg8::EpiF32, pg8::StaticOrder, true, true>(lds, g, S, E);
    }
    __syncthreads();
    if (IN(8)) ph_sample_outproj(p, lds, bid, nblk);
    SEAM(8);
    if (IN(9)) ph_ln(p, bid, nblk);
#undef IN
#undef SEAM
}

extern "C" void kernel_launch(void* const* d_in, const int* in_sizes, int n_in, void* d_out, int out_size, void* d_ws, size_t ws_size, hipStream_t stream) {
    static int grid = 0;
    if (grid == 0) {
        if (n_in != 17 || out_size != O_END || ws_size < WS_END) { fprintf(stderr, "kernel_launch: unexpected sizes (n_in %d out %d ws %zu)\n", n_in, out_size, ws_size); grid = -1; return; }
        int dev = 0, cus = 0, per_cu = 0;
        if (hipGetDevice(&dev) != hipSuccess || hipDeviceGetAttribute(&cus, hipDeviceAttributeMultiprocessorCount, dev) != hipSuccess) { grid = -1; return; }
        if (hipFuncSetAttribute((const void*)fwd_kernel, hipFuncAttributeMaxDynamicSharedMemorySize, LDS_BYTES) != hipSuccess) { fprintf(stderr, "kernel_launch: hipFuncSetAttribute failed\n"); grid = -1; return; }
        if (hipOccupancyMaxActiveBlocksPerMultiprocessor(&per_cu, (const void*)fwd_kernel, 512, LDS_BYTES) != hipSuccess || per_cu < 1) fprintf(stderr, "kernel_launch: occupancy query says %d\n", per_cu);
        (void)hipGetLastError();
        grid = cus;
    }
    if (grid < 0) return;
    (void)hipMemsetAsync((char*)d_ws + WS_CTL, 0, CTL_ZERO_BYTES, stream);
    Params p{};
    p.x_prompt = (const float*)d_in[0]; p.x_sample = (const float*)d_in[1]; p.cache_k = (const float*)d_in[2]; p.cache_v = (const float*)d_in[3]; p.page_table = (const int*)d_in[4];
    p.state_delta = (const float*)d_in[5]; p.state_conv = (const float*)d_in[6]; p.w_in = (const float*)d_in[7]; p.conv_w = (const float*)d_in[8]; p.a_log = (const float*)d_in[9];
    p.dt_bias = (const float*)d_in[10]; p.delta_norm_w = (const float*)d_in[11]; p.diff_lambda = (const float*)d_in[12]; p.diff_norm_w = (const float*)d_in[13]; p.w_out = (const float*)d_in[14];
    p.ln_g = (const float*)d_in[15]; p.ln_b = (const float*)d_in[16]; p.out = (float*)d_out; p.ws = (unsigned char*)d_ws;
    const int cuts6[7] = {0, 1, 3, 6, 7, 9, 10};
    const int nl = (N_LAUNCHES == 1) ? 1 : 6;
    for (int li = 0; li < nl; ++li) {
        p.ph_lo = (N_LAUNCHES == 1) ? 0 : cuts6[li]; p.ph_hi = (N_LAUNCHES == 1) ? N_PHASES : cuts6[li + 1];
        hipLaunchKernelGGL(fwd_kernel, dim3(grid), dim3(512), LDS_BYTES, stream, p);
        const hipError_t le = hipPeekAtLastError();
        if (le != hipSuccess) { fprintf(stderr, "kernel_launch: launch %d failed: %s\n", li, hipGetErrorName(le)); break; }
    }
}
```

```cpp
#include <hip/hip_runtime.h>
#include <cstdio>
#include <cstdint>
#include <cmath>
namespace pg8 {
#define PG8_LAS __attribute__((address_space(3)))
typedef unsigned short bf16_t;
typedef short bf16x8 __attribute__((ext_vector_type(8)));
typedef float f32x4 __attribute__((ext_vector_type(4)));
typedef unsigned u32x4 __attribute__((ext_vector_type(4)));
constexpr int BM = 256, BK = 64, HALF = 128, HTB = HALF * BK * 2  , STAGE_BYTES = 8 * HTB, NXCD = 8, WGM = 8;

__host__ __device__ __forceinline__ int lds_byte(int r, int c) { const int st = (r >> 4) * 2 + (c >> 5), rr = r & 15, cc = c & 31, ob = rr * 64 + cc * 2; return st * 1024 + (ob ^ (((ob >> 9) & 1) << 5)); }
__host__ __device__ __forceinline__ void stage_rc(int b, int& R, int& C) { const int st = b / 1024, sb = b % 1024, swz = sb ^ (((sb >> 9) & 1) << 5); R = (st >> 1) * 16 + swz / 64; C = (st & 1) * 32 + (swz % 64) / 2; }
__host__ __device__ __forceinline__ int perm32(int rho) { const int n = rho >> 4, i = rho & 15; return 8 * (i >> 2) + 4 * n + (i & 3); }

struct Unit { int pm, pn; };
struct Gemm { const bf16_t* A; const bf16_t* Bt; int M, N, K; };

struct StaticOrder {
    int nM, nN, nwg, G, c;
    __host__ __device__ void init(int M, int N, int G_, int c_) { nM = M / BM; nN = N / BM; nwg = nM * nN; G = G_; c = c_; }
    __host__ __device__ bool next(int i, Unit& u) const {
        const long L = (long)i * G + c; if (L >= nwg) return false;
        int wgid = (int)L; { const int q = nwg / NXCD, r = nwg % NXCD, xcd = wgid % NXCD, off = wgid / NXCD; wgid = (xcd < r ? xcd * (q + 1) : r * (q + 1) + (xcd - r) * q) + off; }
        const int nig = WGM * nN, gid = wgid / nig, fm = gid * WGM, gsz = (nM - fm) < WGM ? (nM - fm) : WGM;
        u.pm = fm + ((wgid % nig) % gsz); u.pn = (wgid % nig) / gsz; return true;
    }
    __device__ __forceinline__ void a_ready(const Unit&) const {}
    __device__ __forceinline__ void done(const Unit&) const {}
};

__device__ __forceinline__ unsigned cvt_pk_bf16(float lo, float hi) { unsigned r; asm volatile("v_cvt_pk_bf16_f32 %0, %1, %2" : "=v"(r) : "v"(lo), "v"(hi)); return r; }
typedef float f32x2 __attribute__((ext_vector_type(2)));
typedef float f32x4g __attribute__((ext_vector_type(4)));
__device__ __forceinline__ float silu_f(float x) { return x / (1.f + __expf(-x)); }
struct EpiH {
    static constexpr bool PERM = true, AFTER_DRAIN = false;
    bf16_t* H; float* out; const float* rope;
    __device__ __forceinline__ void operator()(const f32x4 (&acc)[2][2][4][2], const Unit& u, int wr, int wc, int fr, int fq) const {
        const int row0 = u.pm * BM + wr * 64 + fr;
        const int region = u.pn >> 1;
        constexpr int O_KP = 16809984, O_VP = 25198592, O_CP = 34111488;
        constexpr float QSC = 0.125f * 1.4426950408889634f;
#pragma unroll
        for (int ai = 0; ai < 2; ++ai)
#pragma unroll
            for (int m = 0; m < 4; ++m) {
                const int row = row0 + ai * HALF + m * 16; const int t = row & 2047;
#pragma unroll
                for (int bj = 0; bj < 2; ++bj) {
                    const int c0 = u.pn * BM + bj * HALF + wc * 32 + 8 * fq;
                    f32x4 v0 = acc[ai][bj][m][0], v1 = acc[ai][bj][m][1];
                    if (region <= 1) {
                        const int pos = c0 & 63, chunk = (c0 & 511) >> 6;
                        if (pos < 16) {
                            const int f0 = pos >> 1;
                            const f32x4 cs0 = *(const f32x4*)(rope + (size_t)t * 16 + f0 * 2), cs1 = *(const f32x4*)(rope + (size_t)t * 16 + f0 * 2 + 4);
                            f32x4 a, b;
                            a[0] = v0[0] * cs0[0] - v0[1] * cs0[1]; b[0] = v0[1] * cs0[0] + v0[0] * cs0[1];
                            a[1] = v0[2] * cs0[2] - v0[3] * cs0[3]; b[1] = v0[3] * cs0[2] + v0[2] * cs0[3];
                            a[2] = v1[0] * cs1[0] - v1[1] * cs1[1]; b[2] = v1[1] * cs1[0] + v1[0] * cs1[1];
                            a[3] = v1[2] * cs1[2] - v1[3] * cs1[3]; b[3] = v1[3] * cs1[2] + v1[2] * cs1[3];
                            if (region == 1) { float* kp = out + O_KP + (size_t)row * 512 + chunk * 64 + f0; *(f32x4*)kp = a; *(f32x4*)(kp + 8) = b; }
                            v0 = (f32x4){a[0], b[0], a[1], b[1]}; v1 = (f32x4){a[2], b[2], a[3], b[3]};
                        } else if (region == 1) { float* kp = out + O_KP + (size_t)row * 512 + chunk * 64 + pos; *(f32x4*)kp = v0; *(f32x4*)(kp + 4) = v1; }
                        if (region == 0) { v0 = v0 * QSC; v1 = v1 * QSC; }
                    } else if (region == 2) {
                        float* vp = out + O_VP + (size_t)row * 512 + (c0 - 1024); *(f32x4*)vp = v0; *(f32x4*)(vp + 4) = v1;
                    } else if (region == 3 || region == 7) {
#pragma unroll
                        for (int j = 0; j < 4; ++j) { v0[j] = silu_f(v0[j]); v1[j] = silu_f(v1[j]); }
                    } else {
                        if (t >= 2045) { float* cp = out + O_CP + (size_t)((row >> 11) * 3 + (t - 2045)) * 1536 + (c0 - 2048); *(f32x4*)cp = v0; *(f32x4*)(cp + 4) = v1; }
                    }
                    u32x4 w; w.x = cvt_pk_bf16(v0[0], v0[1]); w.y = cvt_pk_bf16(v0[2], v0[3]); w.z = cvt_pk_bf16(v1[0], v1[1]); w.w = cvt_pk_bf16(v1[2], v1[3]);
                    *(u32x4*)(H + (size_t)row * 4096 + c0) = w;
                }
            }
    }
};
struct EpiF32 {
    static constexpr bool PERM = false, AFTER_DRAIN = false;
    float* C; int ldc;
    __device__ __forceinline__ void operator()(const f32x4 (&acc)[2][2][4][2], const Unit& u, int wr, int wc, int fr, int fq) const {
        const int row0 = u.pm * BM + wr * 64 + fr, col0 = u.pn * BM + wc * 32 + 4 * fq;
#pragma unroll
        for (int ai = 0; ai < 2; ++ai)
#pragma unroll
            for (int m = 0; m < 4; ++m) { float* rowp = C + (size_t)(row0 + ai * HALF + m * 16) * ldc + col0;
#pragma unroll
                for (int bj = 0; bj < 2; ++bj)
#pragma unroll
                    for (int n = 0; n < 2; ++n) *(f32x4*)(rowp + bj * HALF + n * 16) = acc[ai][bj][m][n]; }
    }
};
template <class Epi, class Sched, bool ALIGN_EPI = false, bool SP2 = false>
__device__ __forceinline__ void gemm_phase(PG8_LAS unsigned char* lds, const Gemm g, const Sched& S, const Epi& E) {
    const int tid = threadIdx.x, wid = __builtin_amdgcn_readfirstlane(tid >> 6), lane = tid & 63, wr = wid >> 2, wc = wid & 3, fr = lane & 15, fq = lane >> 4;
    const int K = g.K, nt = K / BK;
    unsigned voffA[2], voffB[2];
#pragma unroll
    for (int i = 0; i < 2; ++i) { int R, C; stage_rc(tid * 16 + i * 8192, R, C); const int Rb = Epi::PERM ? ((R & ~31) + perm32(R & 31)) : R;
        voffA[i] = (unsigned)(R * K + C) * 2u; voffB[i] = (unsigned)(Rb * K + C) * 2u; }
    const size_t kstep = (size_t)(BK * 2);
    const size_t hstep = (size_t)HALF * K * 2;
    const size_t tstep = 2 * hstep;
    const unsigned ldsw = (unsigned)wid * 1024u;
    const int aoff = lds_byte(wr * 64 + fr, fq * 8), boff = lds_byte(wc * 32 + fr, fq * 8);
#define PG8_SA(b, h) (((b) * 2 + (h)) * HTB)
#define PG8_SB(b, h) ((4 + (b) * 2 + (h)) * HTB)
#define PG8_STAGE(bufoff, gbase, voff) do { _Pragma("unroll") for (int _i = 0; _i < 2; ++_i) \
        __builtin_amdgcn_global_load_lds((const unsigned*)((const char*)(gbase) + (voff)[_i]), (PG8_LAS unsigned*)(lds + (bufoff) + ldsw + _i * 8192), 16, 0, 0); } while (0)
#define PG8_LDA(dst, b, h) do { _Pragma("unroll") for (int m = 0; m < 4; ++m) _Pragma("unroll") for (int k = 0; k < 2; ++k) dst[m][k] = *(const PG8_LAS bf16x8*)(lds + PG8_SA(b, h) + aoff + m * 2048 + k * 1024); } while (0)
#define PG8_LDB(dst, b, h) do { _Pragma("unroll") for (int n = 0; n < 2; ++n) _Pragma("unroll") for (int k = 0; k < 2; ++k) dst[n][k] = *(const PG8_LAS bf16x8*)(lds + PG8_SB(b, h) + boff + n * 2048 + k * 1024); } while (0)
#define PG8_MMA(ai, bj, At, Bt) do { __builtin_amdgcn_s_setprio(1); _Pragma("unroll") for (int m = 0; m < 4; ++m) _Pragma("unroll") for (int n = 0; n < 2; ++n) _Pragma("unroll") for (int k = 0; k < 2; ++k) \
        acc[ai][bj][m][n] = __builtin_amdgcn_mfma_f32_16x16x32_bf16(Bt[n][k], At[m][k], acc[ai][bj][m][n], 0, 0, 0); __builtin_amdgcn_s_setprio(0); } while (0)
#define PG8_WAIT_V(n) asm volatile("s_waitcnt vmcnt(" #n ")" ::: "memory")
#define PG8_WAIT_L(n) asm volatile("s_waitcnt lgkmcnt(" #n ")" ::: "memory")
#define PG8_BAR __builtin_amdgcn_s_barrier()
#define PG8_SCHED __builtin_amdgcn_sched_barrier(0)
    Unit cur, nxt; int ui = 0;
    if (!S.next(0, cur)) return;
    f32x4 acc[2][2][4][2];
#pragma unroll
    for (int a = 0; a < 2; ++a)
#pragma unroll
        for (int b = 0; b < 2; ++b)
#pragma unroll
            for (int m = 0; m < 4; ++m)
#pragma unroll
                for (int n = 0; n < 2; ++n) acc[a][b][m][n] = (f32x4){0.f, 0.f, 0.f, 0.f};
    bf16x8 At[4][2], B0[2][2], B1[2][2];
    const char* cA = (const char*)g.A + (size_t)cur.pm * tstep; const char* cB = (const char*)g.Bt + (size_t)cur.pn * tstep;
    S.a_ready(cur);
    if constexpr (SP2) {
        PG8_STAGE(PG8_SB(0, 0), cB, voffB); PG8_STAGE(PG8_SB(0, 1), cB + hstep, voffB); PG8_STAGE(PG8_SA(0, 0), cA, voffA); PG8_STAGE(PG8_SA(0, 1), cA + hstep, voffA);
        if (wr == 1) PG8_BAR;
        PG8_WAIT_V(2); PG8_BAR;
        PG8_STAGE(PG8_SB(1, 0), cB + kstep, voffB); PG8_STAGE(PG8_SA(1, 0), cA + kstep, voffA); PG8_STAGE(PG8_SB(1, 1), cB + hstep + kstep, voffB);
        PG8_WAIT_V(6); PG8_BAR;
    } else {
        PG8_STAGE(PG8_SB(0, 0), cB, voffB); PG8_STAGE(PG8_SA(0, 0), cA, voffA); PG8_STAGE(PG8_SB(0, 1), cB + hstep, voffB); PG8_STAGE(PG8_SA(0, 1), cA + hstep, voffA);
        if (wr == 1) PG8_BAR;
        PG8_WAIT_V(4); PG8_BAR;
        PG8_STAGE(PG8_SB(1, 0), cB + kstep, voffB); PG8_STAGE(PG8_SA(1, 0), cA + kstep, voffA); PG8_STAGE(PG8_SB(1, 1), cB + hstep + kstep, voffB);
        PG8_WAIT_V(6); PG8_BAR;
    }
    for (;;) {
        const bool has_next = S.next(ui + 1, nxt);
        const char* nA = has_next ? (const char*)g.A + (size_t)nxt.pm * tstep : cA; const char* nB = has_next ? (const char*)g.Bt + (size_t)nxt.pn * tstep : cB;
        for (int t = 0; t < nt; t += 2) {
            const bool last = (t == nt - 2);
            const char* a1 = cA + (size_t)(t + 1) * kstep;
            const char* a2 = last ? nA : cA + (size_t)(t + 2) * kstep; const char* b2 = last ? nB : cB + (size_t)(t + 2) * kstep;
            const char* a3 = a2 + kstep; const char* b3 = b2 + kstep;
            if (last && has_next) S.a_ready(nxt);
            if constexpr (SP2) {
            PG8_LDB(B0, 0, 0); PG8_LDB(B1, 0, 1); PG8_SCHED; PG8_LDA(At, 0, 0); PG8_STAGE(PG8_SA(1, 1), a1 + hstep, voffA);
            PG8_WAIT_V(8); PG8_WAIT_L(0); PG8_BAR; PG8_MMA(0, 0, At, B0); PG8_MMA(0, 1, At, B1); PG8_BAR; PG8_SCHED;
            PG8_LDA(At, 0, 1); PG8_STAGE(PG8_SB(0, 0), b2, voffB); PG8_STAGE(PG8_SB(0, 1), b2 + hstep, voffB); PG8_STAGE(PG8_SA(0, 0), a2, voffA);
            PG8_WAIT_V(8); PG8_WAIT_L(0); PG8_BAR; PG8_MMA(1, 0, At, B0); PG8_MMA(1, 1, At, B1); PG8_BAR; PG8_SCHED;
            PG8_LDB(B0, 1, 0); PG8_LDB(B1, 1, 1); PG8_SCHED; PG8_LDA(At, 1, 0); PG8_STAGE(PG8_SA(0, 1), a2 + hstep, voffA);
            PG8_WAIT_V(8); PG8_WAIT_L(0); PG8_BAR; PG8_MMA(0, 0, At, B0); PG8_MMA(0, 1, At, B1); PG8_BAR; PG8_SCHED;
            PG8_LDA(At, 1, 1); PG8_STAGE(PG8_SB(1, 0), b3, voffB); PG8_STAGE(PG8_SB(1, 1), b3 + hstep, voffB); PG8_STAGE(PG8_SA(1, 0), a3, voffA);
            PG8_WAIT_V(8); PG8_WAIT_L(0); PG8_BAR; PG8_MMA(1, 0, At, B0); PG8_MMA(1, 1, At, B1); PG8_BAR; PG8_SCHED;
            } else {
            PG8_LDB(B0, 0, 0); PG8_SCHED; PG8_LDA(At, 0, 0); PG8_STAGE(PG8_SA(1, 1), a1 + hstep, voffA);
            PG8_WAIT_L(8); PG8_BAR; PG8_WAIT_L(0); PG8_MMA(0, 0, At, B0); PG8_BAR; PG8_SCHED;
            PG8_LDB(B1, 0, 1); PG8_STAGE(PG8_SB(0, 0), b2, voffB);
            PG8_BAR; PG8_WAIT_L(0); PG8_MMA(0, 1, At, B1); PG8_BAR;
            PG8_LDA(At, 0, 1); PG8_STAGE(PG8_SA(0, 0), a2, voffA);
            PG8_BAR; PG8_WAIT_L(0); PG8_MMA(1, 0, At, B0); PG8_BAR; PG8_SCHED;
            PG8_STAGE(PG8_SB(0, 1), b2 + hstep, voffB);
            PG8_WAIT_V(6); PG8_BAR; PG8_MMA(1, 1, At, B1); PG8_BAR;
            PG8_LDB(B0, 1, 0); PG8_SCHED; PG8_LDA(At, 1, 0); PG8_STAGE(PG8_SA(0, 1), a2 + hstep, voffA);
            PG8_WAIT_L(8); PG8_BAR; PG8_WAIT_L(0); PG8_MMA(0, 0, At, B0); PG8_BAR; PG8_SCHED;
            PG8_LDB(B1, 1, 1); PG8_STAGE(PG8_SB(1, 0), b3, voffB);
            PG8_BAR; PG8_WAIT_L(0); PG8_MMA(0, 1, At, B1); PG8_BAR;
            PG8_LDA(At, 1, 1); PG8_STAGE(PG8_SA(1, 0), a3, voffA);
            PG8_BAR; PG8_WAIT_L(0); PG8_MMA(1, 0, At, B0); PG8_BAR; PG8_SCHED;
            PG8_STAGE(PG8_SB(1, 1), b3 + hstep, voffB);
            PG8_WAIT_V(6); PG8_BAR; PG8_MMA(1, 1, At, B1); PG8_BAR;
            }
        }
        if constexpr (ALIGN_EPI) { if (wr == 0) PG8_BAR; }
        if constexpr (!Epi::AFTER_DRAIN) { E(acc, cur, wr, wc, fr, fq); S.done(cur); }
        if (!has_next) break;
#pragma unroll
        for (int a = 0; a < 2; ++a)
#pragma unroll
            for (int b = 0; b < 2; ++b)
#pragma unroll
                for (int m = 0; m < 4; ++m)
#pragma unroll
                    for (int n = 0; n < 2; ++n) acc[a][b][m][n] = (f32x4){0.f, 0.f, 0.f, 0.f};
        cur = nxt; cA = nA; cB = nB; ++ui;
        if constexpr (ALIGN_EPI) { if (wr == 1) PG8_BAR; }
    }
    PG8_WAIT_V(0);
    if constexpr (!ALIGN_EPI) { if (wr == 0) PG8_BAR; }
    PG8_BAR;
    if constexpr (Epi::AFTER_DRAIN) { E.fused(acc, cur, wr, wc, fr, fq, lds, wid, lane); S.done(cur); }
#undef PG8_SA
#undef PG8_SB
#undef PG8_STAGE
#undef PG8_LDA
#undef PG8_LDB
#undef PG8_MMA
#undef PG8_WAIT_V
#undef PG8_WAIT_L
#undef PG8_BAR
#undef PG8_SCHED
}
}
#define LAS __attribute__((address_space(3)))
using pg8::silu_f;
typedef unsigned short bf16_t;
typedef float f32x4 __attribute__((ext_vector_type(4)));
typedef float f32x2 __attribute__((ext_vector_type(2)));
typedef unsigned u32x4 __attribute__((ext_vector_type(4)));
typedef unsigned u32x2 __attribute__((ext_vector_type(2)));
constexpr int D = 1024, NB = 8, SEQ = 2048, MP = NB * SEQ, NS = 32, PIN = 4104, NH = 4096;
constexpr int NPAGES = 64, PAGE = 128;
constexpr int O_Y = 0, O_YS = 16777216, O_KP = 16809984, O_VP = 25198592, O_SP = 33587200, O_CP = 34111488, O_KS = 34148352, O_VS = 34164736, O_SS = 34181120, O_CS = 36278272, O_END = 36425728;
constexpr size_t MiB = 1u << 20;
constexpr size_t WS_CTL = 0, CTL_ZERO_BYTES = 1 * MiB;
constexpr size_t WS_WTIN = 1 * MiB, WS_WTOUT = 9 * MiB, WS_ROPE = 11 * MiB, WS_BETA = 12 * MiB, WS_G = 13 * MiB, WS_HSP = 14 * MiB  ;
constexpr size_t WS_QS = 20 * MiB  , WS_GSA = 21 * MiB  , WS_MIXS = 22 * MiB  ;
constexpr size_t WS_XB = 32 * MiB, WS_H = 64 * MiB, WS_OA = 192 * MiB, WS_OB = 224 * MiB, WS_MIXIN = 256 * MiB, WS_MIX = 296 * MiB, WS_PART = 368 * MiB, WS_SCAN = 400 * MiB, WS_U = 456 * MiB, WS_DL = 488 * MiB, WS_END = 489 * MiB;
constexpr int CW_BAR = 4096;
constexpr int LDS_BYTES = 147456;
constexpr int MISC_OFF = 131072 + 320;
constexpr float LAM_INIT = 0.2f;

struct Params {
    const float *x_prompt, *x_sample, *cache_k, *cache_v; const int* page_table; const float *state_delta, *state_conv, *w_in, *conv_w, *a_log, *dt_bias, *delta_norm_w, *diff_lambda, *diff_norm_w, *w_out, *ln_g, *ln_b;
    float* out; unsigned char* ws; int ph_lo, ph_hi;
};
__device__ __forceinline__ float bf2f(bf16_t b) { return __uint_as_float(((unsigned)b) << 16); }
__device__ __forceinline__ unsigned f2bf(float f) { unsigned u = __float_as_uint(f); return (u + 0x7fffu + ((u >> 16) & 1u)) >> 16; }
__device__ __forceinline__ unsigned pk2(float lo, float hi) { return f2bf(lo) | (f2bf(hi) << 16); }
__device__ __forceinline__ float wave_sum(float v) {
#pragma unroll
    for (int o = 1; o < 64; o <<= 1) v += __shfl_xor(v, o);
    return v;
}
__device__ __forceinline__ unsigned pk2f(float lo, float hi) { typedef float f2_ __attribute__((ext_vector_type(2))); typedef __bf16 b2_ __attribute__((ext_vector_type(2))); f2_ v = {lo, hi}; b2_ b = __builtin_convertvector(v, b2_); return __builtin_bit_cast(unsigned, b); }
#define LDS_WAIT() asm volatile("s_waitcnt lgkmcnt(0)" ::: "memory")
#define XB_TMO      128
#define XB_XCNT(j)  (256  + 64 * (j))
#define XB_XSUB(j)  (1280 + 64 * (j))
#define XB_XGEN(j)  (2304 + 64 * (j))
#define XB_TOP      3328
#define XB_TOPGEN   3392
#define XCD_BAR_WORDS 3456
#define XB_SPIN_CAP (1u << 18)
__device__ __forceinline__ unsigned xb_ld(unsigned* p)              { return __hip_atomic_load(p, __ATOMIC_RELAXED, __HIP_MEMORY_SCOPE_AGENT); }
__device__ __forceinline__ unsigned xb_add(unsigned* p, unsigned v) { return __hip_atomic_fetch_add(p, v, __ATOMIC_RELAXED, __HIP_MEMORY_SCOPE_AGENT); }
__device__ __forceinline__ unsigned xb_xcc_id() { return (unsigned)__builtin_amdgcn_s_getreg((3 << 11) | 20) & 0xFu; }
#define XB_SPIN(cond, bar) do { unsigned _sp = 0; while (cond) { __builtin_amdgcn_s_sleep(1); \
    if ((++_sp & 255u) == 0u) { if (xb_ld(&(bar)[XB_TMO])) break; if (_sp > XB_SPIN_CAP) { atomicAdd(&(bar)[XB_TMO], 1u); break; } } } } while (0)

struct XcdBarrier {
    unsigned* bar; unsigned x;
    volatile LAS unsigned* st;
};

__device__ __forceinline__ XcdBarrier xcd_barrier_post(unsigned* bar, volatile LAS unsigned* st) {
    XcdBarrier b; b.bar = bar; b.x = xb_xcc_id(); b.st = st;
    if (threadIdx.x == 0) (void)xb_add(&bar[XB_XCNT(b.x)], 1u);
    return b;
}
__device__ __forceinline__ void xcd_barrier_complete(unsigned* bar, unsigned x, unsigned& nloc, unsigned& nx) {
    const unsigned G = gridDim.x * gridDim.y * gridDim.z;
    unsigned sum, cnt, mine, sp = 0u;
    for (;;) {
        sum = 0u; cnt = 0u; mine = 0u;
#pragma unroll
        for (unsigned j = 0; j < 16; ++j) { const unsigned c = xb_ld(&bar[XB_XCNT(j)]); sum += c; cnt += (c > 0u) ? 1u : 0u; mine = (j == x) ? c : mine; }
        if (sum == G) break;
        __builtin_amdgcn_s_sleep(1);
        if ((++sp & 255u) == 0u) { if (xb_ld(&bar[XB_TMO])) break; if (sp > XB_SPIN_CAP) { atomicAdd(&bar[XB_TMO], 1u); break; } }
    }
    nloc = mine > 0u ? mine : 1u; nx = cnt > 0u ? cnt : 1u;
}

__device__ __forceinline__ void xcd_barrier(const XcdBarrier& b) {
    asm volatile("s_waitcnt vmcnt(0)" ::: "memory");
    __syncthreads();
    if (threadIdx.x == 0) {
        unsigned* bar = b.bar;
        __builtin_amdgcn_s_waitcnt(0);
        unsigned nloc = b.st[0], nx = b.st[1];
        if (nloc == 0u) { xcd_barrier_complete(bar, b.x, nloc, nx); b.st[0] = nloc; b.st[1] = nx; }
        const unsigned old = xb_add(&bar[XB_XSUB(b.x)], 1u);
        const unsigned gen = old / nloc;
        if (old + 1u == (gen + 1u) * nloc) {
            __builtin_amdgcn_fence(__ATOMIC_RELEASE, "agent");
            asm volatile("s_waitcnt vmcnt(0)" ::: "memory");
            const unsigned og = xb_add(&bar[XB_TOP], 1u);
            const unsigned tg = og / nx;
            if (og + 1u == (tg + 1u) * nx) xb_add(&bar[XB_TOPGEN], 1u);
            else XB_SPIN(xb_ld(&bar[XB_TOPGEN]) == tg, bar);
            __builtin_amdgcn_fence(__ATOMIC_ACQUIRE, "agent");
            xb_add(&bar[XB_XGEN(b.x)], 1u);
            asm volatile("s_waitcnt vmcnt(0)" ::: "memory");
        } else {
            XB_SPIN(xb_ld(&bar[XB_XGEN(b.x)]) == gen, bar);
            __builtin_amdgcn_fence(__ATOMIC_ACQUIRE, "agent");
            asm volatile("s_waitcnt vmcnt(0)" ::: "memory");
        }
    }
    __syncthreads();
}
__device__ __forceinline__ void p0_transpose_item(const float* W, int K, int ldw, int N, bf16_t* WT, LAS float* scr, int item, int lane, bool permq) {
    const int nblk = N / 32, kb = item / nblk, nb = item % nblk, k0 = 64 * kb, n0 = 32 * nb;
    int sc = lane & 31;
    if (permq && n0 < 1024 && (n0 & 32) == 0 && sc < 16) sc = (sc >> 1) + 8 * (sc & 1);
#pragma unroll 8
    for (int i = 0; i < 32; ++i) { const int kk = 2 * i + (lane >> 5); scr[kk * 33 + (lane & 31)] = W[(size_t)(k0 + kk) * ldw + n0 + sc]; }
    LDS_WAIT(); asm volatile("" ::: "memory");
    const int c = lane & 7;
#pragma unroll
    for (int j = 0; j < 4; ++j) { const int n = (lane >> 3) + 8 * j; const LAS float* s = scr + (8 * c) * 33 + n;
        u32x4 o; o.x = pk2(s[0 * 33], s[1 * 33]); o.y = pk2(s[2 * 33], s[3 * 33]); o.z = pk2(s[4 * 33], s[5 * 33]); o.w = pk2(s[6 * 33], s[7 * 33]);
        *(u32x4*)(WT + (size_t)(n0 + n) * K + k0 + 8 * c) = o; }
    LDS_WAIT(); asm volatile("" ::: "memory");
}
__device__ __forceinline__ void ph_prologue(const Params& p, LAS unsigned char* lds, int bid, int nblk) {
    const int tid = threadIdx.x, lane = tid & 63, wave = tid >> 6;
    const int gw = bid * 8 + wave, ngw = nblk * 8;
    bf16_t* WTI = (bf16_t*)(p.ws + WS_WTIN); bf16_t* WTO = (bf16_t*)(p.ws + WS_WTOUT);
    { LAS float* scr = (LAS float*)(lds + wave * 8704);
      constexpr int I_IN = 16 * 128, I_OUT = 16 * 32;
      for (int it = gw; it < I_IN + I_OUT; it += ngw) {
          if (it < I_IN) p0_transpose_item(p.w_in, 1024, PIN, 4096, WTI, scr, it, lane, true);
          else p0_transpose_item(p.w_out, 1024, 1024, 1024, WTO, scr, it - I_IN, lane, false);
      } }
    LAS float* wb = (LAS float*)(lds + 69632);
    for (int i = tid; i < 8192; i += 512) wb[i] = p.w_in[(size_t)(i >> 3) * PIN + 4096 + (i & 7)];
    __syncthreads();
    { bf16_t* XB = (bf16_t*)(p.ws + WS_XB); float* BETA = (float*)(p.ws + WS_BETA); float* GG = (float*)(p.ws + WS_G);
      for (int row = gw; row < MP + NS; row += ngw) {
          const float* src = row < MP ? p.x_prompt + (size_t)row * D : p.x_sample + (size_t)(row - MP) * D;
          f32x4 v[4]; float acc[8];
#pragma unroll
          for (int c = 0; c < 8; ++c) acc[c] = 0.f;
#pragma unroll
          for (int j = 0; j < 4; ++j) v[j] = *(const f32x4*)(src + 4 * lane + 256 * j);
          if (row < MP) {
#pragma unroll
              for (int j = 0; j < 4; ++j) { u32x2 w; w.x = pk2(v[j][0], v[j][1]); w.y = pk2(v[j][2], v[j][3]); *(u32x2*)(XB + (size_t)row * D + 4 * lane + 256 * j) = w; } }
#pragma unroll
          for (int j = 0; j < 4; ++j)
#pragma unroll
              for (int e = 0; e < 4; ++e) { const int k = 256 * j + 4 * lane + e; const f32x4 w0 = *(const LAS f32x4*)(wb + k * 8), w1 = *(const LAS f32x4*)(wb + k * 8 + 4); const float xv = v[j][e];
                  acc[0] += xv * w0[0]; acc[1] += xv * w0[1]; acc[2] += xv * w0[2]; acc[3] += xv * w0[3]; acc[4] += xv * w1[0]; acc[5] += xv * w1[1]; acc[6] += xv * w1[2]; acc[7] += xv * w1[3]; }
#pragma unroll
          for (int c = 0; c < 8; ++c) acc[c] = wave_sum(acc[c]);
          float s = acc[0];
#pragma unroll
          for (int c = 1; c < 8; ++c) s = (lane == c) ? acc[c] : s;
          if (lane < 4) BETA[(size_t)row * 4 + lane] = 1.f / (1.f + expf(-s));
          else if (lane < 8) { const int h = lane - 4; const float xx = s + p.dt_bias[h]; const float sp = xx > 20.f ? xx : log1pf(expf(xx)); GG[(size_t)row * 4 + h] = -expf(p.a_log[h]) * sp; }
      } }
    { float* RT = (float*)(p.ws + WS_ROPE);
      for (int i = bid * 512 + tid; i < 2049 * 8; i += nblk * 512) { const int pi = i >> 3, f = i & 7; const float pos = pi < 2048 ? (float)pi : 8192.f;
          const float inv = (float)pow(500000.0, -(double)f / 8.0); const float ang = pos * inv; RT[2 * i] = (float)cos((double)ang); RT[2 * i + 1] = (float)sin((double)ang); } }
    { float* HSP = (float*)(p.ws + WS_HSP); LAS float* xs = (LAS float*)(lds + 102400);
      for (int item = bid; item < 72; item += nblk) { const int ks = item / 9, cb = item % 9, col = cb * 512 + tid;
          __syncthreads();
          for (int i = tid; i < 4096; i += 512) xs[i] = p.x_sample[(size_t)(i >> 7) * D + ks * 128 + (i & 127)];
          __syncthreads();
          if (col < PIN) { float acc[32];
#pragma unroll
              for (int r = 0; r < 32; ++r) acc[r] = 0.f;
              for (int kk = 0; kk < 128; kk += 4) { const float* wp = p.w_in + (size_t)(ks * 128 + kk) * PIN + col; const float w0 = wp[0], w1 = wp[PIN], w2 = wp[2 * PIN], w3 = wp[3 * PIN];
#pragma unroll
                  for (int r = 0; r < 32; ++r) { const f32x4 x4 = *(const LAS f32x4*)(xs + r * 128 + kk); acc[r] += x4[0] * w0 + x4[1] * w1 + x4[2] * w2 + x4[3] * w3; } }
#pragma unroll
              for (int r = 0; r < 32; ++r) HSP[(size_t)(ks * 32 + r) * PIN + col] = acc[r]; }
      } }
}
__device__ __forceinline__ void ph_sample_post(const Params& p, LAS unsigned char* lds, int bid, int nblk) {
    const int tid = threadIdx.x, t = tid & 127, cat = tid >> 7;
    LAS float* raw = (LAS float*)lds;
    LAS float* cv3 = raw + 1024;
    LAS float* gzb = cv3 + 384;
    LAS float* red = gzb + 128;
    LAS float* red2 = red + 512;
    LAS float* ov = red2 + 512;
    const float* HSP = (const float*)(p.ws + WS_HSP); const float* RT = (const float*)(p.ws + WS_ROPE) + 2048 * 16;
    float* QS = (float*)(p.ws + WS_QS); float* GSA = (float*)(p.ws + WS_GSA);
    const float* BETA = (const float*)(p.ws + WS_BETA); const float* GG = (const float*)(p.ws + WS_G);
    bf16_t* MIXIN = (bf16_t*)(p.ws + WS_MIXIN);
    for (int u = bid; u < NS * 4; u += nblk) {
        const int b = u >> 2, h = u & 3;
        __syncthreads();
        { const int col1 = cat * 512 + h * 128 + t, col2 = (cat + 4) * 512 + h * 128 + t; float s1 = 0.f, s2 = 0.f;
          for (int ks = 0; ks < 8; ++ks) { s1 += HSP[(size_t)(ks * 32 + b) * PIN + col1]; s2 += HSP[(size_t)(ks * 32 + b) * PIN + col2]; }
          raw[cat * 128 + t] = s1; raw[(cat + 4) * 128 + t] = s2; }
        __syncthreads();
        {
            const float x = raw[cat * 128 + t]; const int d = t & 63;
            if (cat <= 1) { float o = x;
                if (d < 8) { const float x2 = raw[cat * 128 + t + 8]; o = x * RT[2 * d] - x2 * RT[2 * d + 1]; }
                else if (d < 16) { const float x1 = raw[cat * 128 + t - 8]; const int f = d - 8; o = x * RT[2 * f] + x1 * RT[2 * f + 1]; }
                if (cat == 0) QS[b * 512 + h * 128 + t] = o * 0.125f; else p.out[O_KS + b * 512 + h * 128 + t] = o; }
            else if (cat == 2) p.out[O_VS + b * 512 + h * 128 + t] = x;
            else GSA[b * 512 + h * 128 + t] = silu_f(x);
            const float y = raw[(cat + 4) * 128 + t];
            if (cat < 3) { const int ch = cat * 512 + h * 128 + t; const float* sc = p.state_conv + (size_t)b * 3 * 1536 + ch;
                const float s0 = sc[0], s1 = sc[1536], s2 = sc[3072];
                const float val = s0 * p.conv_w[ch] + s1 * p.conv_w[1536 + ch] + s2 * p.conv_w[3072 + ch] + y * p.conv_w[4608 + ch];
                cv3[cat * 128 + t] = silu_f(val);
                float* co = p.out + O_CS + (size_t)b * 3 * 1536 + ch; co[0] = s1; co[1536] = s2; co[3072] = y; }
            else gzb[t] = silu_f(y);
        }
        __syncthreads();
        float sq = 0.f, sk = 0.f;
        for (int i = 0; i < 128; ++i) { const float a = cv3[i], c = cv3[128 + i]; sq += a * a; sk += c * c; }
        const float nq = rsqrtf(sq + 1e-6f) * 0.08838834764831845f, nk = rsqrtf(sk + 1e-6f);
        const float beta = BETA[(size_t)(MP + b) * 4 + h], eg = expf(GG[(size_t)(MP + b) * 4 + h]);
        const int dv = t, g4 = cat;
        float S[32]; const float* S0 = p.state_delta + ((size_t)(b * 4 + h) * 128 + g4 * 32) * 128 + dv;
        float part = 0.f;
#pragma unroll
        for (int i = 0; i < 32; ++i) { S[i] = S0[(size_t)i * 128]; part += S[i] * cv3[128 + g4 * 32 + i]; }
        red[g4 * 128 + dv] = part;
        __syncthreads();
        const float r = (red[dv] + red[128 + dv] + red[256 + dv] + red[384 + dv]) * nk;
        const float vnew = beta * (cv3[256 + dv] - eg * r);
        float part2 = 0.f; float* S1 = p.out + O_SS + ((size_t)(b * 4 + h) * 128 + g4 * 32) * 128 + dv;
#pragma unroll
        for (int i = 0; i < 32; ++i) { S[i] = eg * S[i] + (cv3[128 + g4 * 32 + i] * nk) * vnew; S1[(size_t)i * 128] = S[i]; part2 += S[i] * cv3[g4 * 32 + i]; }
        red2[g4 * 128 + dv] = part2;
        __syncthreads();
        const float o = (red2[dv] + red2[128 + dv] + red2[256 + dv] + red2[384 + dv]) * nq;
        if (g4 == 0) ov[dv] = o;
        __syncthreads();
        if (g4 == 0) { float ss = 0.f; for (int i = 0; i < 128; ++i) ss += ov[i] * ov[i];
            const float rn = rsqrtf(ss * (1.f / 128.f) + 1e-6f);
            MIXIN[(size_t)(MP + b) * D + 512 + h * 128 + dv] = (bf16_t)f2bf(o * rn * p.delta_norm_w[dv] * gzb[dv]); }
    }
}
typedef short bf16x8v __attribute__((ext_vector_type(8)));
typedef short s16x4v __attribute__((ext_vector_type(4)));
typedef float f32x16 __attribute__((ext_vector_type(16)));
__device__ __forceinline__ int crow16(int r, int hi) { return (r & 3) + 8 * (r >> 2) + 4 * hi; }
__device__ __forceinline__ int perm32pos(int a) { return 8 * ((a >> 2) & 3) + 4 * (a >> 4) + (a & 3); }
constexpr int SC_WN = 0, SC_QG = 16384, SC_KGT = 32768, SC_ATT = 49152, SC_UNIT = 57344;
__device__ __forceinline__ s16x4v lds_tr16(LAS const unsigned char* p) { return __builtin_bit_cast(s16x4v, __builtin_amdgcn_ds_read_tr16_b64_v4i16((LAS s16x4v*)p)); }
__device__ __forceinline__ void ph_delta_prep(const Params& p, LAS unsigned char* lds, int bid, int nblk) {
    const int tid0 = threadIdx.x, wave = __builtin_amdgcn_readfirstlane(tid0 >> 6);
    LAS unsigned char* QN = lds; LAS unsigned char* KN = lds + 16384; LAS unsigned char* VBT = lds + 32768; LAS unsigned char* KBG = lds + 49152;
    LAS float* AM = (LAS float*)(lds + 65536); LAS unsigned char* TB = lds + 81920; LAS float* GCS = (LAS float*)(lds + 90112); LAS float* EGC = GCS + 64; LAS float* BET = GCS + 128;
    const bf16_t* H = (const bf16_t*)(p.ws + WS_H); const float* BETA = (const float*)(p.ws + WS_BETA); const float* GG = (const float*)(p.ws + WS_G);
    unsigned char* SCAN = p.ws + WS_SCAN; float* UG = (float*)(p.ws + WS_U); float* DLG = (float*)(p.ws + WS_DL);
    for (int u = bid; u < 1024; u += nblk) {
        const int n = u & 31, bh = u >> 5, b = bh >> 2, h = bh & 3; const size_t rowc = (size_t)b * SEQ + n * 64;
        int tid = tid0; asm volatile("" : "+v"(tid));
        const int lane = tid & 63;
        __syncthreads();
        float gc;
        { float x = GG[(rowc + lane) * 4 + h];
#pragma unroll
          for (int o = 1; o < 64; o <<= 1) { const float y = __shfl_up(x, o); if (lane >= o) x += y; }
          gc = x; }
        const float gcl = __shfl(gc, 63);
        if (wave == 0) { GCS[lane] = gc; EGC[lane] = __expf(gc); BET[lane] = BETA[(rowc + lane) * 4 + h]; if (lane == 0) DLG[u] = __expf(gcl); }
        {
            float cw[4][3][2];
#pragma unroll
            for (int j = 0; j < 4; ++j)
#pragma unroll
                for (int w3 = 0; w3 < 3; ++w3) { const f32x2 c2 = *(const f32x2*)(p.conv_w + j * 1536 + w3 * 512 + h * 128 + 2 * lane); cw[j][w3][0] = c2[0]; cw[j][w3][1] = c2[1]; }
            float xin[11][3][2];
#pragma unroll
            for (int rr = 0; rr < 11; ++rr) { const int tt = n * 64 + wave * 8 - 3 + rr;
#pragma unroll
                for (int w3 = 0; w3 < 3; ++w3) { unsigned v = 0u; if (tt >= 0) v = *(const unsigned*)(H + ((size_t)b * SEQ + tt) * 4096 + 2048 + w3 * 512 + h * 128 + 2 * lane);
                    xin[rr][w3][0] = __uint_as_float(v << 16); xin[rr][w3][1] = __uint_as_float(v & 0xffff0000u); } }
#pragma unroll
            for (int i = 0; i < 8; ++i) { const int tt = wave * 8 + i; float val[3][2];
#pragma unroll
                for (int w3 = 0; w3 < 3; ++w3)
#pragma unroll
                    for (int e = 0; e < 2; ++e) val[w3][e] = silu_f(xin[i][w3][e] * cw[0][w3][e] + xin[i + 1][w3][e] * cw[1][w3][e] + xin[i + 2][w3][e] * cw[2][w3][e] + xin[i + 3][w3][e] * cw[3][w3][e]);
                const float nq = rsqrtf(wave_sum(val[0][0] * val[0][0] + val[0][1] * val[0][1]) + 1e-6f) * 0.08838834764831845f;
                const float nk = rsqrtf(wave_sum(val[1][0] * val[1][0] + val[1][1] * val[1][1]) + 1e-6f);
                const float bt = BETA[(rowc + tt) * 4 + h], egt = __expf(__shfl(gc, tt));
                const int d = 2 * lane, sw = (((d >> 3) ^ (tt & 15)) * 16) + (d & 7) * 2;
                *(LAS unsigned*)(QN + tt * 256 + sw) = pk2(val[0][0] * nq, val[0][1] * nq);
                *(LAS unsigned*)(KN + tt * 256 + sw) = pk2(val[1][0] * nk, val[1][1] * nk);
                const int tro = (d >> 5) * 4096 + tt * 64 + (d & 31) * 2;
                *(LAS unsigned*)(VBT + tro) = pk2(val[2][0] * bt, val[2][1] * bt);
                *(LAS unsigned*)(KBG + tro) = pk2(val[1][0] * nk * bt * egt, val[1][1] * nk * bt * egt);
            }
        }
        __syncthreads();
        { const int which = wave >> 2, ti = (wave >> 1) & 1, tj = wave & 1, r32 = lane & 31, hh = lane >> 5;
          const int ra = 32 * ti + r32, rb = 32 * tj + r32; LAS const unsigned char* Ab = which ? QN : KN;
          f32x16 acc = {0.f, 0.f, 0.f, 0.f, 0.f, 0.f, 0.f, 0.f, 0.f, 0.f, 0.f, 0.f, 0.f, 0.f, 0.f, 0.f};
#pragma unroll
          for (int s = 0; s < 8; ++s) { const bf16x8v a = *(LAS const bf16x8v*)(Ab + ra * 256 + (((2 * s + hh) ^ (ra & 15)) * 16)), bb = *(LAS const bf16x8v*)(KN + rb * 256 + (((2 * s + hh) ^ (rb & 15)) * 16));
              acc = __builtin_amdgcn_mfma_f32_32x32x16_bf16(a, bb, acc, 0, 0, 0); }
          const int j = 32 * tj + r32; const float gcj = GCS[j];
          unsigned char* attg = SCAN + (size_t)u * SC_UNIT + SC_ATT; const int posj = 32 * (j >> 5) + perm32pos(j & 31);
#pragma unroll
          for (int r = 0; r < 16; ++r) { const int i = 32 * ti + crow16(r, hh); const float dec = (i >= j) ? __expf(GCS[i] - gcj) : 0.f;
              if (which == 0) AM[i * 64 + j] = (i > j) ? BET[i] * acc[r] * dec : 0.f;
              else *(bf16_t*)(attg + i * 128 + (((posj >> 3) ^ ((i >> 1) & 7)) * 16) + (posj & 7) * 2) = (bf16_t)f2bf(acc[r] * dec); } }
        { unsigned char* qgg = SCAN + (size_t)u * SC_UNIT + SC_QG; unsigned char* kgg = SCAN + (size_t)u * SC_UNIT + SC_KGT;
#pragma unroll
          for (int k2 = 0; k2 < 2; ++k2) { const int job = tid + 512 * k2;
              { const int t = job >> 4, pp = job & 15, s = pp >> 2, kq = pp & 3, da = 32 * s + 4 * kq, db = da + 16; const float eg = EGC[t];
                const u32x2 xa = *(LAS const u32x2*)(QN + t * 256 + (((da >> 3) ^ (t & 15)) * 16) + (da & 7) * 2), xb = *(LAS const u32x2*)(QN + t * 256 + (((db >> 3) ^ (t & 15)) * 16) + (db & 7) * 2);
                u32x4 o; o.x = pk2(__uint_as_float(xa.x << 16) * eg, __uint_as_float(xa.x & 0xffff0000u) * eg); o.y = pk2(__uint_as_float(xa.y << 16) * eg, __uint_as_float(xa.y & 0xffff0000u) * eg);
                o.z = pk2(__uint_as_float(xb.x << 16) * eg, __uint_as_float(xb.x & 0xffff0000u) * eg); o.w = pk2(__uint_as_float(xb.y << 16) * eg, __uint_as_float(xb.y & 0xffff0000u) * eg);
                *(u32x4*)(qgg + t * 256 + ((pp ^ (t & 15)) * 16)) = o; }
              { const int dk = job >> 3, pp = job & 7, s = pp >> 2, kq = pp & 3; float v8[8];
#pragma unroll
                for (int jj = 0; jj < 8; ++jj) { const int t = 32 * s + 16 * (jj >> 2) + 4 * kq + (jj & 3);
                    v8[jj] = bf2f(*(LAS const bf16_t*)(KN + t * 256 + (((dk >> 3) ^ (t & 15)) * 16) + (dk & 7) * 2)) * __expf(gcl - GCS[t]); }
                u32x4 o; o.x = pk2(v8[0], v8[1]); o.y = pk2(v8[2], v8[3]); o.z = pk2(v8[4], v8[5]); o.w = pk2(v8[6], v8[7]);
                *(u32x4*)(kgg + dk * 128 + ((pp ^ ((dk >> 1) & 7)) * 16)) = o; } } }
        __syncthreads();
#ifndef PREP_NO_S3
        if (wave == 0) { float tc[64]; int lz; asm volatile("v_mov_b32 %0, 0" : "=v"(lz));
            LAS const float* AMv = AM + lz;
#pragma unroll
            for (int i = 0; i < 64; ++i) { float a = (i == lane) ? 1.f : 0.f;
#pragma unroll
                for (int j = 0; j < i; ++j) a -= AMv[i * 64 + j] * tc[j];
                tc[i] = a; }
#pragma unroll
            for (int i = 0; i < 64; ++i) *(LAS bf16_t*)(TB + i * 128 + ((((lane >> 3) ^ ((i >> 1) & 7))) * 16) + (lane & 7) * 2) = (bf16_t)f2bf(tc[i]); }
#endif
        __syncthreads();
        { const int sel = wave >> 2, tj = wave & 3, r32 = lane & 31, hh = lane >> 5; LAS const unsigned char* Bb = (sel ? KBG : VBT) + tj * 4096 + ((lane >> 4) & 1) * 32 + (lane & 3) * 8 + (8 * hh + ((lane & 15) >> 2)) * 64;
          unsigned char* wng = SCAN + (size_t)u * SC_UNIT + SC_WN; float* ug = UG + (size_t)u * 8192;
#pragma unroll
          for (int ti = 0; ti < 2; ++ti) { const int ra = 32 * ti + r32;
              f32x16 acc = {0.f, 0.f, 0.f, 0.f, 0.f, 0.f, 0.f, 0.f, 0.f, 0.f, 0.f, 0.f, 0.f, 0.f, 0.f, 0.f};
#pragma unroll
              for (int s = 0; s < 4; ++s) { const bf16x8v a = *(LAS const bf16x8v*)(TB + ra * 128 + (((2 * s + hh) ^ ((ra >> 1) & 7)) * 16));
                  const s16x4v lo = lds_tr16(Bb + s * 1024), hi4 = lds_tr16(Bb + s * 1024 + 256);
                  const bf16x8v bb = {lo[0], lo[1], lo[2], lo[3], hi4[0], hi4[1], hi4[2], hi4[3]};
                  acc = __builtin_amdgcn_mfma_f32_32x32x16_bf16(a, bb, acc, 0, 0, 0); }
              const int e = 32 * tj + r32;
#pragma unroll
              for (int r = 0; r < 16; ++r) { const int t = 32 * ti + crow16(r, hh);
                  if (sel == 0) ug[(((e >> 4) * 4 + (t >> 4)) * 64 + ((t & 15) >> 2) * 16 + (e & 15)) * 4 + (t & 3)] = acc[r];
                  else { const int pos = 32 * (e >> 5) + perm32pos(e & 31); *(bf16_t*)(wng + t * 256 + (((pos >> 3) ^ (t & 15)) * 16) + (pos & 7) * 2) = (bf16_t)f2bf(-acc[r]); } } } }
    }
}
__device__ __forceinline__ void ph_delta_scan(const Params& p, LAS unsigned char* lds, int bid, int nblk) {
    const int tid = threadIdx.x, lane = tid & 63, wave = __builtin_amdgcn_readfirstlane(tid >> 6), r16 = lane & 15, kq = lane >> 4;
    const unsigned char* SCAN = p.ws + WS_SCAN; const float* UG = (const float*)(p.ws + WS_U); const float* DLG = (const float*)(p.ws + WS_DL); float* OB = (float*)(p.ws + WS_OB);
    typedef float f32x4v __attribute__((ext_vector_type(4)));
    for (int u = bid; u < 32; u += nblk) {
        const int b = u >> 2, h = u & 3; const size_t rowb = (size_t)b * SEQ;
        f32x4v S[8];
#pragma unroll
        for (int i = 0; i < 8; ++i) S[i] = (f32x4v){0.f, 0.f, 0.f, 0.f};
        __syncthreads();
        { const unsigned char* src = SCAN + (size_t)(u * 32) * SC_UNIT;
#pragma unroll
          for (int i = 0; i < 7; ++i) __builtin_amdgcn_global_load_lds((const unsigned*)(src + i * 8192 + wave * 1024 + lane * 16), (LAS unsigned*)(lds + i * 8192 + wave * 1024), 16, 0, 0); }
        asm volatile("s_waitcnt vmcnt(0)" ::: "memory"); __syncthreads();
        for (int n = 0; n < 32; ++n) {
            LAS const unsigned char* buf = lds + (n & 1) * SC_UNIT;
            if (n + 1 < 32) { const unsigned char* src = SCAN + (size_t)(u * 32 + n + 1) * SC_UNIT; LAS unsigned char* dst = lds + ((n + 1) & 1) * SC_UNIT;
#pragma unroll
                for (int i = 0; i < 7; ++i) __builtin_amdgcn_global_load_lds((const unsigned*)(src + i * 8192 + wave * 1024 + lane * 16), (LAS unsigned*)(dst + i * 8192 + wave * 1024), 16, 0, 0); }
            const float* ug = UG + (size_t)(u * 32 + n) * 8192 + (size_t)(wave * 4) * 256 + lane * 4;
            f32x4v vn[4];
#pragma unroll
            for (int mt = 0; mt < 4; ++mt) vn[mt] = *(const f32x4v*)(ug + mt * 256);
            const float dl = DLG[u * 32 + n];
            bf16x8v Sb[4];
#pragma unroll
            for (int s = 0; s < 4; ++s) { u32x4 w; w.x = pk2(S[2 * s][0], S[2 * s][1]); w.y = pk2(S[2 * s][2], S[2 * s][3]); w.z = pk2(S[2 * s + 1][0], S[2 * s + 1][1]); w.w = pk2(S[2 * s + 1][2], S[2 * s + 1][3]); Sb[s] = __builtin_bit_cast(bf16x8v, w); }
            f32x4v o[4];
#pragma unroll
            for (int mt = 0; mt < 4; ++mt) { const int t = 16 * mt + r16; o[mt] = (f32x4v){0.f, 0.f, 0.f, 0.f};
#pragma unroll
                for (int s = 0; s < 4; ++s) { const int off = t * 256 + (((4 * s + kq) ^ r16) * 16);
                    const bf16x8v aw = *(LAS const bf16x8v*)(buf + SC_WN + off), aq = *(LAS const bf16x8v*)(buf + SC_QG + off);
                    vn[mt] = __builtin_amdgcn_mfma_f32_16x16x32_bf16(aw, Sb[s], vn[mt], 0, 0, 0);
                    o[mt] = __builtin_amdgcn_mfma_f32_16x16x32_bf16(aq, Sb[s], o[mt], 0, 0, 0); } }
            bf16x8v Vb[2];
#pragma unroll
            for (int s = 0; s < 2; ++s) { u32x4 w; w.x = pk2(vn[2 * s][0], vn[2 * s][1]); w.y = pk2(vn[2 * s][2], vn[2 * s][3]); w.z = pk2(vn[2 * s + 1][0], vn[2 * s + 1][1]); w.w = pk2(vn[2 * s + 1][2], vn[2 * s + 1][3]); Vb[s] = __builtin_bit_cast(bf16x8v, w); }
#pragma unroll
            for (int mt = 0; mt < 4; ++mt) { const int t = 16 * mt + r16;
#pragma unroll
                for (int s = 0; s < 2; ++s) { const bf16x8v aa = *(LAS const bf16x8v*)(buf + SC_ATT + t * 128 + (((4 * s + kq) ^ ((t >> 1) & 7)) * 16)); o[mt] = __builtin_amdgcn_mfma_f32_16x16x32_bf16(aa, Vb[s], o[mt], 0, 0, 0); }
                float* op = OB + (rowb + n * 64 + 16 * mt + 4 * kq) * 512 + h * 128 + wave * 16 + r16;
#pragma unroll
                for (int r = 0; r < 4; ++r) op[(size_t)r * 512] = o[mt][r]; }
#pragma unroll
            for (int i = 0; i < 8; ++i) { const int dk = 16 * i + r16; S[i] = S[i] * dl;
#pragma unroll
                for (int s = 0; s < 2; ++s) { const bf16x8v ak = *(LAS const bf16x8v*)(buf + SC_KGT + dk * 128 + (((4 * s + kq) ^ ((dk >> 1) & 7)) * 16)); S[i] = __builtin_amdgcn_mfma_f32_16x16x32_bf16(ak, Vb[s], S[i], 0, 0, 0); } }
            asm volatile("s_waitcnt vmcnt(0)" ::: "memory"); __syncthreads();
        }
        float* SP = p.out + O_SP + (size_t)(b * 4 + h) * 16384;
#pragma unroll
        for (int i = 0; i < 8; ++i)
#pragma unroll
            for (int r = 0; r < 4; ++r) SP[(size_t)(16 * i + 4 * kq + r) * 128 + wave * 16 + r16] = S[i][r];
    }
}
__device__ __forceinline__ void attn_unit(const bf16_t* __restrict__ H, bf16_t* __restrict__ OA, LAS unsigned char* lds, int b, int c, int qb, int tid) {
    const int lane = tid & 63, wid = __builtin_amdgcn_readfirstlane(tid >> 6), r32 = lane & 31, hi = lane >> 5, h = c >> 1;
    const size_t rowb = (size_t)b * SEQ; const int q0 = qb * 256, NT = (q0 + 256) / 64;
    bf16x8v qr[4];
    { const bf16_t* qp = H + (rowb + q0 + 32 * wid + r32) * 4096 + c * 64 + 8 * hi;
#pragma unroll
      for (int d0 = 0; d0 < 4; ++d0) qr[d0] = *(const bf16x8v*)(qp + 16 * d0); }
    f32x16 o[4];
#pragma unroll
    for (int d0 = 0; d0 < 4; ++d0)
#pragma unroll
        for (int r = 0; r < 16; ++r) o[d0][r] = 0.f;
    float mhat = -INFINITY, lsum = 0.f;
    LAS float* wsf = (LAS float*)(lds + 49152) + wid * 64;
    const bf16_t* ksrc = H + (rowb + lane) * 4096 + 512 + c * 64 + wid * 8;
    const int pi0 = wid * 2, pi1 = wid * 2 + 1;
    const bf16_t* vsrc0 = H + (rowb + 16 * (pi0 & 3) + (lane >> 2)) * 4096 + 1024 + h * 128 + (pi0 >> 2) * 32 + (lane & 3) * 8;
    const bf16_t* vsrc1 = H + (rowb + 16 * (pi1 & 3) + (lane >> 2)) * 4096 + 1024 + h * 128 + (pi1 >> 2) * 32 + (lane & 3) * 8;
    LAS unsigned char* kdst = lds + wid * 1024; LAS unsigned char* vdst0 = lds + 16384 + (pi0 >> 2) * 4096 + (pi0 & 3) * 1024; LAS unsigned char* vdst1 = lds + 16384 + (pi1 >> 2) * 4096 + (pi1 & 3) * 1024;
#define ATT_ISSUE(t, slot) do { const size_t go_ = (size_t)(t) * 64 * 4096; \
        __builtin_amdgcn_global_load_lds((const unsigned*)(ksrc + go_), (LAS unsigned*)(kdst + (slot) * 8192), 16, 0, 0); \
        __builtin_amdgcn_global_load_lds((const unsigned*)(vsrc0 + go_), (LAS unsigned*)(vdst0 + (slot) * 16384), 16, 0, 0); \
        __builtin_amdgcn_global_load_lds((const unsigned*)(vsrc1 + go_), (LAS unsigned*)(vdst1 + (slot) * 16384), 16, 0, 0); } while (0)
    const int vb = ((lane >> 4) & 1) * 32 + (lane & 3) * 8 + (4 * hi + ((lane & 15) >> 2)) * 64;
    __syncthreads();
    ATT_ISSUE(0, 0);
    for (int t = 0; t < NT; ++t) {
        asm volatile("s_waitcnt vmcnt(0)" ::: "memory"); __syncthreads();
        if (t + 1 < NT) ATT_ISSUE(t + 1, (t + 1) & 1);
        LAS const unsigned char* Ks = lds + (t & 1) * 8192; LAS const unsigned char* Vs = lds + 16384 + (t & 1) * 16384 + vb;
        f32x16 p0, p1;
#pragma unroll
        for (int r = 0; r < 16; ++r) { p0[r] = 0.f; p1[r] = 0.f; }
#pragma unroll
        for (int d0 = 0; d0 < 4; ++d0) { const bf16x8v b0 = *(LAS const bf16x8v*)(Ks + (2 * d0 + hi) * 1024 + r32 * 16), b1 = *(LAS const bf16x8v*)(Ks + (2 * d0 + hi) * 1024 + r32 * 16 + 512);
            p0 = __builtin_amdgcn_mfma_f32_32x32x16_bf16(b0, qr[d0], p0, 0, 0, 0); p1 = __builtin_amdgcn_mfma_f32_32x32x16_bf16(b1, qr[d0], p1, 0, 0, 0); }
        if (t >= NT - 4) { const int kb = 64 * (t - (NT - 4)) + 4 * hi, qrel = 32 * wid + r32;
#pragma unroll
            for (int r = 0; r < 16; ++r) { const int kv = kb + (r & 3) + 8 * (r >> 2); if (kv > qrel) p0[r] = -INFINITY; if (kv + 32 > qrel) p1[r] = -INFINITY; } }
        float rm = fmaxf(p0[0], p1[0]);
#pragma unroll
        for (int r = 1; r < 16; ++r) rm = fmaxf(rm, fmaxf(p0[r], p1[r]));
        rm = fmaxf(rm, __shfl_xor(rm, 32));
        if (__any(rm > mhat + 8.f)) {
            const float mnew = (rm > mhat + 8.f) ? rm : mhat, alpha = exp2f(mhat - mnew);
            lsum *= alpha; mhat = mnew;
            if (hi == 0) wsf[r32] = alpha;
            LDS_WAIT();
#pragma unroll
            for (int r = 0; r < 16; ++r) { const float a = wsf[crow16(r, hi)];
#pragma unroll
                for (int d0 = 0; d0 < 4; ++d0) o[d0][r] *= a; }
        }
        float ps = 0.f;
#pragma unroll
        for (int r = 0; r < 16; ++r) { p0[r] = exp2f(p0[r] - mhat); p1[r] = exp2f(p1[r] - mhat); ps += p0[r] + p1[r]; }
        lsum += ps;
        bf16x8v pw[4];
        { u32x4 w; w.x = pk2f(p0[0], p0[1]); w.y = pk2f(p0[2], p0[3]); w.z = pk2f(p0[4], p0[5]); w.w = pk2f(p0[6], p0[7]); pw[0] = __builtin_bit_cast(bf16x8v, w);
          w.x = pk2f(p0[8], p0[9]); w.y = pk2f(p0[10], p0[11]); w.z = pk2f(p0[12], p0[13]); w.w = pk2f(p0[14], p0[15]); pw[1] = __builtin_bit_cast(bf16x8v, w);
          w.x = pk2f(p1[0], p1[1]); w.y = pk2f(p1[2], p1[3]); w.z = pk2f(p1[4], p1[5]); w.w = pk2f(p1[6], p1[7]); pw[2] = __builtin_bit_cast(bf16x8v, w);
          w.x = pk2f(p1[8], p1[9]); w.y = pk2f(p1[10], p1[11]); w.z = pk2f(p1[12], p1[13]); w.w = pk2f(p1[14], p1[15]); pw[3] = __builtin_bit_cast(bf16x8v, w); }
#pragma unroll
        for (int d0 = 0; d0 < 4; ++d0)
#pragma unroll
            for (int ks = 0; ks < 4; ++ks) { const s16x4v lo = lds_tr16(Vs + d0 * 4096 + ks * 1024), hi4 = lds_tr16(Vs + d0 * 4096 + ks * 1024 + 512);
                const bf16x8v bb = {lo[0], lo[1], lo[2], lo[3], hi4[0], hi4[1], hi4[2], hi4[3]};
                o[d0] = __builtin_amdgcn_mfma_f32_32x32x16_bf16(pw[ks], bb, o[d0], 0, 0, 0); }
    }
#undef ATT_ISSUE
    const float ltot = lsum + __shfl_xor(lsum, 32);
    if (hi == 0) wsf[32 + r32] = 1.f / ltot;
    LDS_WAIT();
    bf16_t* op = OA + (rowb + q0 + 32 * wid) * 1024 + c * 128 + r32;
#pragma unroll
    for (int r = 0; r < 16; ++r) { const int qq = crow16(r, hi); const float inv = wsf[32 + qq];
#pragma unroll
        for (int d0 = 0; d0 < 4; ++d0) op[(size_t)qq * 1024 + 32 * d0] = (bf16_t)f2bf(o[d0][r] * inv); }
    LDS_WAIT();
}
__device__ __forceinline__ void ph_attn(const Params& p, LAS unsigned char* lds, int bid, int nblk) {
    const bf16_t* H = (const bf16_t*)(p.ws + WS_H); bf16_t* OA = (bf16_t*)(p.ws + WS_OA);
    for (int pu = bid; pu < 256; pu += nblk) {
        const int bc = pu >> 2, s = pu & 3;
        int tid = threadIdx.x; asm volatile("" : "+v"(tid));
        attn_unit(H, OA, lds, bc >> 3, bc & 7, 7 - s, tid);
        asm volatile("" : "+v"(tid));
        attn_unit(H, OA, lds, bc >> 3, bc & 7, s, tid);
    }
}
__device__ __forceinline__ void ph_decode(const Params& p, LAS unsigned char* lds, int bid, int nblk) {
    const int tid = threadIdx.x, lane = tid & 63, wave = tid >> 6;
    LAS float* sc = (LAS float*)(lds + wave * 4096);
    const float* QS = (const float*)(p.ws + WS_QS); float* PART = (float*)(p.ws + WS_PART);
    for (int wu = bid * 8 + wave; wu < NS * NPAGES; wu += nblk * 8) {
        const int b = wu >> 6;
        const int phys = p.page_table[wu];
        const float* kb = p.cache_k + (size_t)phys * (PAGE * 512); const float* vb = p.cache_v + (size_t)phys * (PAGE * 512);
        const f32x4 q0 = *(const f32x4*)(QS + b * 512 + 4 * lane), q1 = *(const f32x4*)(QS + b * 512 + 256 + 4 * lane);
        for (int t0 = 0; t0 < PAGE; t0 += 8) {
            f32x4 k0[8], k1[8];
#pragma unroll
            for (int i = 0; i < 8; ++i) { k0[i] = __builtin_nontemporal_load((const f32x4*)(kb + (size_t)(t0 + i) * 512 + 4 * lane)); k1[i] = __builtin_nontemporal_load((const f32x4*)(kb + (size_t)(t0 + i) * 512 + 256 + 4 * lane)); }
#pragma unroll
            for (int i = 0; i < 8; ++i) {
                float d0 = k0[i][0] * q0[0] + k0[i][1] * q0[1] + k0[i][2] * q0[2] + k0[i][3] * q0[3];
                float d1 = k1[i][0] * q1[0] + k1[i][1] * q1[1] + k1[i][2] * q1[2] + k1[i][3] * q1[3];
                d0 += __shfl_xor(d0, 8); d1 += __shfl_xor(d1, 8); d0 += __shfl_xor(d0, 4); d1 += __shfl_xor(d1, 4);
                d0 += __shfl_xor(d0, 2); d1 += __shfl_xor(d1, 2); d0 += __shfl_xor(d0, 1); d1 += __shfl_xor(d1, 1);
                if ((lane & 15) == 0) { sc[(t0 + i) * 8 + (lane >> 4)] = d0; sc[(t0 + i) * 8 + 4 + (lane >> 4)] = d1; }
            }
        }
        LDS_WAIT();
        const int c = lane & 7; float mx = -INFINITY, sv[16];
#pragma unroll
        for (int i = 0; i < 16; ++i) { sv[i] = sc[((lane >> 3) + 8 * i) * 8 + c]; mx = fmaxf(mx, sv[i]); }
        mx = fmaxf(mx, __shfl_xor(mx, 8)); mx = fmaxf(mx, __shfl_xor(mx, 16)); mx = fmaxf(mx, __shfl_xor(mx, 32));
        float ls = 0.f;
#pragma unroll
        for (int i = 0; i < 16; ++i) { const float e = __expf(sv[i] - mx); ls += e; sc[((lane >> 3) + 8 * i) * 8 + c] = e; }
        ls += __shfl_xor(ls, 8); ls += __shfl_xor(ls, 16); ls += __shfl_xor(ls, 32);
        LDS_WAIT();
        const int h0 = lane >> 5, h1 = 2 + (lane >> 5);
        f32x4 o00 = {0.f, 0.f, 0.f, 0.f}, o01 = o00, o10 = o00, o11 = o00;
        for (int t0 = 0; t0 < PAGE; t0 += 8) {
            f32x4 v0[8], v1[8];
#pragma unroll
            for (int i = 0; i < 8; ++i) { v0[i] = __builtin_nontemporal_load((const f32x4*)(vb + (size_t)(t0 + i) * 512 + 4 * lane)); v1[i] = __builtin_nontemporal_load((const f32x4*)(vb + (size_t)(t0 + i) * 512 + 256 + 4 * lane)); }
#pragma unroll
            for (int i = 0; i < 8; ++i) { const f32x2 pa = *(const LAS f32x2*)(sc + (t0 + i) * 8 + 2 * h0), pb = *(const LAS f32x2*)(sc + (t0 + i) * 8 + 2 * h1);
                o00 += v0[i] * pa[0]; o01 += v0[i] * pa[1]; o10 += v1[i] * pb[0]; o11 += v1[i] * pb[1]; }
        }
        float* pp = PART + (size_t)wu * 8 * 132;
        *(f32x4*)(pp + (2 * h0) * 132 + 4 * (lane & 31)) = o00; *(f32x4*)(pp + (2 * h0 + 1) * 132 + 4 * (lane & 31)) = o01;
        *(f32x4*)(pp + (2 * h1) * 132 + 4 * (lane & 31)) = o10; *(f32x4*)(pp + (2 * h1 + 1) * 132 + 4 * (lane & 31)) = o11;
        if (lane < 8) { pp[lane * 132 + 128] = mx; pp[lane * 132 + 129] = ls; }
        LDS_WAIT();
    }
}
__device__ __forceinline__ float lambda_of(const Params& p, int lane) {
    const float a = wave_sum(p.diff_lambda[lane] * p.diff_lambda[64 + lane]), b = wave_sum(p.diff_lambda[128 + lane] * p.diff_lambda[192 + lane]);
    return expf(a) - expf(b) + LAM_INIT;
}
__device__ __forceinline__ void ph_gate(const Params& p, LAS unsigned char* lds, int bid, int nblk) {
    const int tid = threadIdx.x, lane = tid & 63, wave = tid >> 6; const int gw = bid * 8 + wave, ngw = nblk * 8;
    const float lam = lambda_of(p, lane);
    const bf16_t* H = (const bf16_t*)(p.ws + WS_H); const bf16_t* OA = (const bf16_t*)(p.ws + WS_OA); const float* OB = (const float*)(p.ws + WS_OB);
    bf16_t* MIXIN = (bf16_t*)(p.ws + WS_MIXIN);
    const float nwa0 = p.diff_norm_w[2 * lane], nwa1 = p.diff_norm_w[2 * lane + 1], nwb0 = p.delta_norm_w[2 * lane], nwb1 = p.delta_norm_w[2 * lane + 1];
    for (int it = gw; it < MP * 4; it += ngw) {
        const int row = it >> 2, h = it & 3;
        const unsigned a0 = *(const unsigned*)(OA + (size_t)row * 1024 + (2 * h) * 128 + 2 * lane), a1 = *(const unsigned*)(OA + (size_t)row * 1024 + (2 * h + 1) * 128 + 2 * lane);
        const unsigned ga = *(const unsigned*)(H + (size_t)row * 4096 + 1536 + h * 128 + 2 * lane), gb = *(const unsigned*)(H + (size_t)row * 4096 + 3584 + h * 128 + 2 * lane);
        const f32x2 ob = *(const f32x2*)(OB + (size_t)row * 512 + h * 128 + 2 * lane);
        const float d0 = bf2f((bf16_t)(a0 & 0xffff)) - lam * bf2f((bf16_t)(a1 & 0xffff)), d1 = bf2f((bf16_t)(a0 >> 16)) - lam * bf2f((bf16_t)(a1 >> 16));
        const float ra = rsqrtf(wave_sum(d0 * d0 + d1 * d1) * (1.f / 128.f) + 1e-5f) * (1.f - LAM_INIT);
        const float rb = rsqrtf(wave_sum(ob[0] * ob[0] + ob[1] * ob[1]) * (1.f / 128.f) + 1e-6f);
        *(unsigned*)(MIXIN + (size_t)row * D + h * 128 + 2 * lane) = pk2(d0 * ra * nwa0 * bf2f((bf16_t)(ga & 0xffff)), d1 * ra * nwa1 * bf2f((bf16_t)(ga >> 16)));
        *(unsigned*)(MIXIN + (size_t)row * D + 512 + h * 128 + 2 * lane) = pk2(ob[0] * rb * nwb0 * bf2f((bf16_t)(gb & 0xffff)), ob[1] * rb * nwb1 * bf2f((bf16_t)(gb >> 16)));
    }
    const float* QS = (const float*)(p.ws + WS_QS); const float* GSA = (const float*)(p.ws + WS_GSA); const float* PART = (const float*)(p.ws + WS_PART);
    for (int it = gw; it < NS * 4; it += ngw) {
        const int b = it >> 2, h = it & 3; float om[2][2];
#pragma unroll
        for (int m = 0; m < 2; ++m) {
            const int c = 2 * h + m;
            const float sself = wave_sum(QS[b * 512 + c * 64 + lane] * p.out[O_KS + b * 512 + c * 64 + lane]);
            float M = sself;
            for (int pg = 0; pg < NPAGES; ++pg) M = fmaxf(M, PART[((size_t)(b * 64 + pg) * 8 + c) * 132 + 128]);
            const float ws = __expf(sself - M); float L = ws;
            float o0 = ws * p.out[O_VS + b * 512 + h * 128 + 2 * lane], o1 = ws * p.out[O_VS + b * 512 + h * 128 + 2 * lane + 1];
            for (int pg = 0; pg < NPAGES; ++pg) { const float* pp = PART + ((size_t)(b * 64 + pg) * 8 + c) * 132; const float w = __expf(pp[128] - M); L += w * pp[129];
                const f32x2 ov = *(const f32x2*)(pp + 2 * lane); o0 += w * ov[0]; o1 += w * ov[1]; }
            om[m][0] = o0 / L; om[m][1] = o1 / L;
        }
        const float d0 = om[0][0] - lam * om[1][0], d1 = om[0][1] - lam * om[1][1];
        const float ra = rsqrtf(wave_sum(d0 * d0 + d1 * d1) * (1.f / 128.f) + 1e-5f) * (1.f - LAM_INIT);
        *(unsigned*)(MIXIN + (size_t)(MP + b) * D + h * 128 + 2 * lane) = pk2(d0 * ra * nwa0 * GSA[b * 512 + h * 128 + 2 * lane], d1 * ra * nwa1 * GSA[b * 512 + h * 128 + 2 * lane + 1]);
    }
}
__device__ __forceinline__ void ph_sample_outproj(const Params& p, LAS unsigned char* lds, int bid, int nblk) {
    const int tid = threadIdx.x, col = tid & 127, kq = tid >> 7;
    LAS float* as = (LAS float*)lds;
    LAS float* red = as + 8192;
    const bf16_t* MIXIN = (const bf16_t*)(p.ws + WS_MIXIN); float* MIXS = (float*)(p.ws + WS_MIXS);
    for (int u = bid; u < 32; u += nblk) {
        const int rg = u >> 3, cb = u & 7;
        __syncthreads();
        for (int i = tid; i < 8192; i += 512) as[i] = bf2f(MIXIN[(size_t)(MP + rg * 8 + (i >> 10)) * D + (i & 1023)]);
        __syncthreads();
        float acc[8];
#pragma unroll
        for (int r = 0; r < 8; ++r) acc[r] = 0.f;
        for (int k = kq * 256; k < kq * 256 + 256; ++k) { const float w = p.w_out[(size_t)k * D + cb * 128 + col];
#pragma unroll
            for (int r = 0; r < 8; ++r) acc[r] += as[r * 1024 + k] * w; }
#pragma unroll
        for (int r = 0; r < 8; ++r) red[(kq * 8 + r) * 128 + col] = acc[r];
        __syncthreads();
        for (int i = tid; i < 1024; i += 512) { const int r = i >> 7, cc = i & 127;
            MIXS[(size_t)(rg * 8 + r) * D + cb * 128 + cc] = red[(0 * 8 + r) * 128 + cc] + red[(1 * 8 + r) * 128 + cc] + red[(2 * 8 + r) * 128 + cc] + red[(3 * 8 + r) * 128 + cc]; }
    }
}
__device__ __forceinline__ void ph_ln(const Params& p, int bid, int nblk) {
    const int tid = threadIdx.x, lane = tid & 63, wave = tid >> 6; const int gw = bid * 8 + wave, ngw = nblk * 8;
    const float* MIX = (const float*)(p.ws + WS_MIX); const float* MIXS = (const float*)(p.ws + WS_MIXS);
    const float alpha = 1.189207115002721f;
    for (int row = gw; row < MP + NS; row += ngw) {
        const float* xr = row < MP ? p.x_prompt + (size_t)row * D : p.x_sample + (size_t)(row - MP) * D;
        const float* mr = row < MP ? MIX + (size_t)row * D : MIXS + (size_t)(row - MP) * D;
        float* orow = row < MP ? p.out + O_Y + (size_t)row * D : p.out + O_YS + (size_t)(row - MP) * D;
        f32x4 v[4]; float s = 0.f;
#pragma unroll
        for (int j = 0; j < 4; ++j) { const f32x4 xv = *(const f32x4*)(xr + 4 * lane + 256 * j), mv = *(const f32x4*)(mr + 4 * lane + 256 * j); v[j] = xv * alpha + mv; s += (v[j][0] + v[j][1]) + (v[j][2] + v[j][3]); }
        const float mean = wave_sum(s) * (1.f / D); float s2 = 0.f;
#pragma unroll
        for (int j = 0; j < 4; ++j) { v[j] = v[j] - mean; s2 += (v[j][0] * v[j][0] + v[j][1] * v[j][1]) + (v[j][2] * v[j][2] + v[j][3] * v[j][3]); }
        const float rstd = rsqrtf(wave_sum(s2) * (1.f / D) + 1e-5f);
#pragma unroll
        for (int j = 0; j < 4; ++j) { const f32x4 gv = *(const f32x4*)(p.ln_g + 4 * lane + 256 * j), bv = *(const f32x4*)(p.ln_b + 4 * lane + 256 * j); *(f32x4*)(orow + 4 * lane + 256 * j) = v[j] * rstd * gv + bv; }
    }
}
#ifndef N_LAUNCHES
#define N_LAUNCHES 1
#endif
constexpr int N_PHASES = 11;
__global__ void __launch_bounds__(512, 2) fwd_kernel(Params p) {
    extern __shared__ __attribute__((aligned(16))) unsigned char lds_raw[];
    LAS unsigned char* lds = (LAS unsigned char*)lds_raw;
    const int tid = threadIdx.x, bid = blockIdx.x, nblk = gridDim.x;
    for (int u = tid; u < (LDS_BYTES - 131072) / 4; u += 512) ((LAS unsigned*)(lds + 131072))[u] = 0u;
    __syncthreads();
    XcdBarrier bar; bar.bar = (unsigned*)(p.ws + WS_CTL) + CW_BAR; bar.x = 0; bar.st = nullptr;
    if (N_LAUNCHES == 1) bar = xcd_barrier_post((unsigned*)(p.ws + WS_CTL) + CW_BAR, (volatile LAS unsigned*)(lds + MISC_OFF) + 8);
    const int lo = p.ph_lo, hi = p.ph_hi;
#ifndef PHASE_MASK
#define PHASE_MASK 0xffff
#endif
#define IN(k) (((PHASE_MASK >> (k)) & 1) && lo <= (k) && (k) < hi)
#define SEAM(k) do { if (IN(k) && IN((k) + 1)) { if (N_LAUNCHES == 1) xcd_barrier(bar); } else __syncthreads(); } while (0)
    if (IN(0)) ph_prologue(p, lds, bid, nblk);
    SEAM(0);
    if (IN(1)) {
        pg8::Gemm g{(const bf16_t*)(p.ws + WS_XB), (const bf16_t*)(p.ws + WS_WTIN), MP, NH, D}; pg8::StaticOrder S; S.init(MP, NH, nblk, bid);
        pg8::EpiH E{(bf16_t*)(p.ws + WS_H), p.out, (const float*)(p.ws + WS_ROPE)};
        pg8::gemm_phase<pg8::EpiH, pg8::StaticOrder, true, true>(lds, g, S, E);
    }
    __syncthreads();
    if (IN(2)) ph_sample_post(p, lds, bid, nblk);
    SEAM(2);
    if (IN(3)) ph_attn(p, lds, bid, nblk);
    __syncthreads();
    if (IN(4)) ph_delta_prep(p, lds, bid, nblk);
    __syncthreads();
    if (IN(5)) ph_decode(p, lds, bid, nblk);
    SEAM(5);
    if (IN(6)) ph_delta_scan(p, lds, bid, nblk);
    SEAM(6);
    if (IN(7)) ph_gate(p, lds, bid, nblk);
    SEAM(7);
    if (IN(8)) {
        pg8::Gemm g{(const bf16_t*)(p.ws + WS_MIXIN), (const bf16_t*)(p.ws + WS_WTOUT), MP, D, D}; pg8::StaticOrder S; S.init(MP, D, nblk, bid);
        pg8::EpiF32 E{(float*)(p.ws + WS_MIX), D};
        pg8::gemm_phase<pg8::EpiF32, pg8::StaticOrder, true, true>(lds, g, S, E);
    }
    __syncthreads();
    if (IN(9)) ph_sample_outproj(p, lds, bid, nblk);
    SEAM(9);
    if (IN(10)) ph_ln(p, bid, nblk);
#undef IN
#undef SEAM
}

extern "C" void kernel_launch(void* const* d_in, const int* in_sizes, int n_in, void* d_out, int out_size, void* d_ws, size_t ws_size, hipStream_t stream) {
    static int grid = 0;
    if (grid == 0) {
        if (n_in != 17 || out_size != O_END || ws_size < WS_END) { fprintf(stderr, "kernel_launch: unexpected sizes (n_in %d out %d ws %zu)\n", n_in, out_size, ws_size); grid = -1; return; }
        int dev = 0, cus = 0, per_cu = 0;
        if (hipGetDevice(&dev) != hipSuccess || hipDeviceGetAttribute(&cus, hipDeviceAttributeMultiprocessorCount, dev) != hipSuccess) { grid = -1; return; }
        if (hipFuncSetAttribute((const void*)fwd_kernel, hipFuncAttributeMaxDynamicSharedMemorySize, LDS_BYTES) != hipSuccess) { fprintf(stderr, "kernel_launch: hipFuncSetAttribute failed\n"); grid = -1; return; }
        if (hipOccupancyMaxActiveBlocksPerMultiprocessor(&per_cu, (const void*)fwd_kernel, 512, LDS_BYTES) != hipSuccess || per_cu < 1) fprintf(stderr, "kernel_launch: occupancy query says %d\n", per_cu);
        (void)hipGetLastError();
        grid = cus;
    }
    if (grid < 0) return;
    (void)hipMemsetAsync((char*)d_ws + WS_CTL, 0, CTL_ZERO_BYTES, stream);
    Params p{};
    p.x_prompt = (const float*)d_in[0]; p.x_sample = (const float*)d_in[1]; p.cache_k = (const float*)d_in[2]; p.cache_v = (const float*)d_in[3]; p.page_table = (const int*)d_in[4];
    p.state_delta = (const float*)d_in[5]; p.state_conv = (const float*)d_in[6]; p.w_in = (const float*)d_in[7]; p.conv_w = (const float*)d_in[8]; p.a_log = (const float*)d_in[9];
    p.dt_bias = (const float*)d_in[10]; p.delta_norm_w = (const float*)d_in[11]; p.diff_lambda = (const float*)d_in[12]; p.diff_norm_w = (const float*)d_in[13]; p.w_out = (const float*)d_in[14];
    p.ln_g = (const float*)d_in[15]; p.ln_b = (const float*)d_in[16]; p.out = (float*)d_out; p.ws = (unsigned char*)d_ws;
    const int cuts6[8] = {0, 1, 3, 6, 7, 8, 10, 11};
    const int nl = (N_LAUNCHES == 1) ? 1 : 7;
    for (int li = 0; li < nl; ++li) {
        p.ph_lo = (N_LAUNCHES == 1) ? 0 : cuts6[li]; p.ph_hi = (N_LAUNCHES == 1) ? N_PHASES : cuts6[li + 1];
        hipLaunchKernelGGL(fwd_kernel, dim3(grid), dim3(512), LDS_BYTES, stream, p);
        const hipError_t le = hipPeekAtLastError();
        if (le != hipSuccess) { fprintf(stderr, "kernel_launch: launch %d failed: %s\n", li, hipGetErrorName(le)); break; }
    }
}
```

```cpp
#include <hip/hip_runtime.h>
#include <cstdio>
#include <cstdint>
#include <cmath>
namespace pg8 {
#define PG8_LAS __attribute__((address_space(3)))
typedef unsigned short bf16_t;
typedef short bf16x8 __attribute__((ext_vector_type(8)));
typedef float f32x4 __attribute__((ext_vector_type(4)));
typedef unsigned u32x4 __attribute__((ext_vector_type(4)));
constexpr int BM = 256, BK = 64, HALF = 128, HTB = HALF * BK * 2  , STAGE_BYTES = 8 * HTB, NXCD = 8, WGM = 8;

__host__ __device__ __forceinline__ int lds_byte(int r, int c) { const int st = (r >> 4) * 2 + (c >> 5), rr = r & 15, cc = c & 31, ob = rr * 64 + cc * 2; return st * 1024 + (ob ^ (((ob >> 9) & 1) << 5)); }
__host__ __device__ __forceinline__ void stage_rc(int b, int& R, int& C) { const int st = b / 1024, sb = b % 1024, swz = sb ^ (((sb >> 9) & 1) << 5); R = (st >> 1) * 16 + swz / 64; C = (st & 1) * 32 + (swz % 64) / 2; }
__host__ __device__ __forceinline__ int perm32(int rho) { const int n = rho >> 4, i = rho & 15; return 8 * (i >> 2) + 4 * n + (i & 3); }

struct Unit { int pm, pn; };
struct Gemm { const bf16_t* A; const bf16_t* Bt; int M, N, K; };

struct StaticOrder {
    int nM, nN, nwg, G, c;
    __host__ __device__ void init(int M, int N, int G_, int c_) { nM = M / BM; nN = N / BM; nwg = nM * nN; G = G_; c = c_; }
    __host__ __device__ bool next(int i, Unit& u) const {
        const long L = (long)i * G + c; if (L >= nwg) return false;
        int wgid = (int)L; { const int q = nwg / NXCD, r = nwg % NXCD, xcd = wgid % NXCD, off = wgid / NXCD; wgid = (xcd < r ? xcd * (q + 1) : r * (q + 1) + (xcd - r) * q) + off; }
        const int nig = WGM * nN, gid = wgid / nig, fm = gid * WGM, gsz = (nM - fm) < WGM ? (nM - fm) : WGM;
        u.pm = fm + ((wgid % nig) % gsz); u.pn = (wgid % nig) / gsz; return true;
    }
    __device__ __forceinline__ void a_ready(const Unit&) const {}
    __device__ __forceinline__ void done(const Unit&) const {}
};

__device__ __forceinline__ unsigned cvt_pk_bf16(float lo, float hi) { unsigned r; asm volatile("v_cvt_pk_bf16_f32 %0, %1, %2" : "=v"(r) : "v"(lo), "v"(hi)); return r; }
typedef float f32x2 __attribute__((ext_vector_type(2)));
typedef float f32x4g __attribute__((ext_vector_type(4)));
__device__ __forceinline__ float silu_f(float x) { return x / (1.f + __expf(-x)); }
struct EpiH {
    static constexpr bool PERM = true, AFTER_DRAIN = false;
    bf16_t* H; float* out; const float* rope;
    __device__ __forceinline__ void operator()(const f32x4 (&acc)[2][2][4][2], const Unit& u, int wr, int wc, int fr, int fq) const {
        const int row0 = u.pm * BM + wr * 64 + fr;
        const int region = u.pn >> 1;
        constexpr int O_KP = 16809984, O_VP = 25198592, O_CP = 34111488;
        constexpr float QSC = 0.125f * 1.4426950408889634f;
#pragma unroll
        for (int ai = 0; ai < 2; ++ai)
#pragma unroll
            for (int m = 0; m < 4; ++m) {
                const int row = row0 + ai * HALF + m * 16; const int t = row & 2047;
#pragma unroll
                for (int bj = 0; bj < 2; ++bj) {
                    const int c0 = u.pn * BM + bj * HALF + wc * 32 + 8 * fq;
                    f32x4 v0 = acc[ai][bj][m][0], v1 = acc[ai][bj][m][1];
                    if (region <= 1) {
                        const int pos = c0 & 63, chunk = (c0 & 511) >> 6;
                        if (pos < 16) {
                            const int f0 = pos >> 1;
                            const f32x4 cs0 = *(const f32x4*)(rope + (size_t)t * 16 + f0 * 2), cs1 = *(const f32x4*)(rope + (size_t)t * 16 + f0 * 2 + 4);
                            f32x4 a, b;
                            a[0] = v0[0] * cs0[0] - v0[1] * cs0[1]; b[0] = v0[1] * cs0[0] + v0[0] * cs0[1];
                            a[1] = v0[2] * cs0[2] - v0[3] * cs0[3]; b[1] = v0[3] * cs0[2] + v0[2] * cs0[3];
                            a[2] = v1[0] * cs1[0] - v1[1] * cs1[1]; b[2] = v1[1] * cs1[0] + v1[0] * cs1[1];
                            a[3] = v1[2] * cs1[2] - v1[3] * cs1[3]; b[3] = v1[3] * cs1[2] + v1[2] * cs1[3];
                            if (region == 1) { float* kp = out + O_KP + (size_t)row * 512 + chunk * 64 + f0; *(f32x4*)kp = a; *(f32x4*)(kp + 8) = b; }
                            v0 = (f32x4){a[0], b[0], a[1], b[1]}; v1 = (f32x4){a[2], b[2], a[3], b[3]};
                        } else if (region == 1) { float* kp = out + O_KP + (size_t)row * 512 + chunk * 64 + pos; *(f32x4*)kp = v0; *(f32x4*)(kp + 4) = v1; }
                        if (region == 0) { v0 = v0 * QSC; v1 = v1 * QSC; }
                    } else if (region == 2) {
                        float* vp = out + O_VP + (size_t)row * 512 + (c0 - 1024); *(f32x4*)vp = v0; *(f32x4*)(vp + 4) = v1;
                    } else if (region == 3 || region == 7) {
#pragma unroll
                        for (int j = 0; j < 4; ++j) { v0[j] = silu_f(v0[j]); v1[j] = silu_f(v1[j]); }
                    } else {
                        if (t >= 2045) { float* cp = out + O_CP + (size_t)((row >> 11) * 3 + (t - 2045)) * 1536 + (c0 - 2048); *(f32x4*)cp = v0; *(f32x4*)(cp + 4) = v1; }
                    }
                    u32x4 w; w.x = cvt_pk_bf16(v0[0], v0[1]); w.y = cvt_pk_bf16(v0[2], v0[3]); w.z = cvt_pk_bf16(v1[0], v1[1]); w.w = cvt_pk_bf16(v1[2], v1[3]);
                    *(u32x4*)(H + (size_t)row * 4096 + c0) = w;
                }
            }
    }
};
struct EpiF32 {
    static constexpr bool PERM = false, AFTER_DRAIN = false;
    float* C; int ldc;
    __device__ __forceinline__ void operator()(const f32x4 (&acc)[2][2][4][2], const Unit& u, int wr, int wc, int fr, int fq) const {
        const int row0 = u.pm * BM + wr * 64 + fr, col0 = u.pn * BM + wc * 32 + 4 * fq;
#pragma unroll
        for (int ai = 0; ai < 2; ++ai)
#pragma unroll
            for (int m = 0; m < 4; ++m) { float* rowp = C + (size_t)(row0 + ai * HALF + m * 16) * ldc + col0;
#pragma unroll
                for (int bj = 0; bj < 2; ++bj)
#pragma unroll
                    for (int n = 0; n < 2; ++n) *(f32x4*)(rowp + bj * HALF + n * 16) = acc[ai][bj][m][n]; }
    }
};
template <class Epi, class Sched, bool ALIGN_EPI = false, bool SP2 = false>
__device__ __forceinline__ void gemm_phase(PG8_LAS unsigned char* lds, const Gemm g, const Sched& S, const Epi& E) {
    const int tid = threadIdx.x, wid = __builtin_amdgcn_readfirstlane(tid >> 6), lane = tid & 63, wr = wid >> 2, wc = wid & 3, fr = lane & 15, fq = lane >> 4;
    const int K = g.K, nt = K / BK;
    unsigned voffA[2], voffB[2];
#pragma unroll
    for (int i = 0; i < 2; ++i) { int R, C; stage_rc(tid * 16 + i * 8192, R, C); const int Rb = Epi::PERM ? ((R & ~31) + perm32(R & 31)) : R;
        voffA[i] = (unsigned)(R * K + C) * 2u; voffB[i] = (unsigned)(Rb * K + C) * 2u; }
    const size_t kstep = (size_t)(BK * 2);
    const size_t hstep = (size_t)HALF * K * 2;
    const size_t tstep = 2 * hstep;
    const unsigned ldsw = (unsigned)wid * 1024u;
    const int aoff = lds_byte(wr * 64 + fr, fq * 8), boff = lds_byte(wc * 32 + fr, fq * 8);
#define PG8_SA(b, h) (((b) * 2 + (h)) * HTB)
#define PG8_SB(b, h) ((4 + (b) * 2 + (h)) * HTB)
#define PG8_STAGE(bufoff, gbase, voff) do { _Pragma("unroll") for (int _i = 0; _i < 2; ++_i) \
        __builtin_amdgcn_global_load_lds((const unsigned*)((const char*)(gbase) + (voff)[_i]), (PG8_LAS unsigned*)(lds + (bufoff) + ldsw + _i * 8192), 16, 0, 0); } while (0)
#define PG8_LDA(dst, b, h) do { _Pragma("unroll") for (int m = 0; m < 4; ++m) _Pragma("unroll") for (int k = 0; k < 2; ++k) dst[m][k] = *(const PG8_LAS bf16x8*)(lds + PG8_SA(b, h) + aoff + m * 2048 + k * 1024); } while (0)
#define PG8_LDB(dst, b, h) do { _Pragma("unroll") for (int n = 0; n < 2; ++n) _Pragma("unroll") for (int k = 0; k < 2; ++k) dst[n][k] = *(const PG8_LAS bf16x8*)(lds + PG8_SB(b, h) + boff + n * 2048 + k * 1024); } while (0)
#define PG8_MMA(ai, bj, At, Bt) do { __builtin_amdgcn_s_setprio(1); _Pragma("unroll") for (int m = 0; m < 4; ++m) _Pragma("unroll") for (int n = 0; n < 2; ++n) _Pragma("unroll") for (int k = 0; k < 2; ++k) \
        acc[ai][bj][m][n] = __builtin_amdgcn_mfma_f32_16x16x32_bf16(Bt[n][k], At[m][k], acc[ai][bj][m][n], 0, 0, 0); __builtin_amdgcn_s_setprio(0); } while (0)
#define PG8_WAIT_V(n) asm volatile("s_waitcnt vmcnt(" #n ")" ::: "memory")
#define PG8_WAIT_L(n) asm volatile("s_waitcnt lgkmcnt(" #n ")" ::: "memory")
#define PG8_BAR __builtin_amdgcn_s_barrier()
#define PG8_SCHED __builtin_amdgcn_sched_barrier(0)
    Unit cur, nxt; int ui = 0;
    if (!S.next(0, cur)) return;
    f32x4 acc[2][2][4][2];
#pragma unroll
    for (int a = 0; a < 2; ++a)
#pragma unroll
        for (int b = 0; b < 2; ++b)
#pragma unroll
            for (int m = 0; m < 4; ++m)
#pragma unroll
                for (int n = 0; n < 2; ++n) acc[a][b][m][n] = (f32x4){0.f, 0.f, 0.f, 0.f};
    bf16x8 At[4][2], B0[2][2], B1[2][2];
    const char* cA = (const char*)g.A + (size_t)cur.pm * tstep; const char* cB = (const char*)g.Bt + (size_t)cur.pn * tstep;
    S.a_ready(cur);
    if constexpr (SP2) {
        PG8_STAGE(PG8_SB(0, 0), cB, voffB); PG8_STAGE(PG8_SB(0, 1), cB + hstep, voffB); PG8_STAGE(PG8_SA(0, 0), cA, voffA); PG8_STAGE(PG8_SA(0, 1), cA + hstep, voffA);
        if (wr == 1) PG8_BAR;
        PG8_WAIT_V(2); PG8_BAR;
        PG8_STAGE(PG8_SB(1, 0), cB + kstep, voffB); PG8_STAGE(PG8_SA(1, 0), cA + kstep, voffA); PG8_STAGE(PG8_SB(1, 1), cB + hstep + kstep, voffB);
        PG8_WAIT_V(6); PG8_BAR;
    } else {
        PG8_STAGE(PG8_SB(0, 0), cB, voffB); PG8_STAGE(PG8_SA(0, 0), cA, voffA); PG8_STAGE(PG8_SB(0, 1), cB + hstep, voffB); PG8_STAGE(PG8_SA(0, 1), cA + hstep, voffA);
        if (wr == 1) PG8_BAR;
        PG8_WAIT_V(4); PG8_BAR;
        PG8_STAGE(PG8_SB(1, 0), cB + kstep, voffB); PG8_STAGE(PG8_SA(1, 0), cA + kstep, voffA); PG8_STAGE(PG8_SB(1, 1), cB + hstep + kstep, voffB);
        PG8_WAIT_V(6); PG8_BAR;
    }
    for (;;) {
        const bool has_next = S.next(ui + 1, nxt);
        const char* nA = has_next ? (const char*)g.A + (size_t)nxt.pm * tstep : cA; const char* nB = has_next ? (const char*)g.Bt + (size_t)nxt.pn * tstep : cB;
        for (int t = 0; t < nt; t += 2) {
            const bool last = (t == nt - 2);
            const char* a1 = cA + (size_t)(t + 1) * kstep;
            const char* a2 = last ? nA : cA + (size_t)(t + 2) * kstep; const char* b2 = last ? nB : cB + (size_t)(t + 2) * kstep;
            const char* a3 = a2 + kstep; const char* b3 = b2 + kstep;
            if (last && has_next) S.a_ready(nxt);
            if constexpr (SP2) {
            PG8_LDB(B0, 0, 0); PG8_LDB(B1, 0, 1); PG8_SCHED; PG8_LDA(At, 0, 0); PG8_STAGE(PG8_SA(1, 1), a1 + hstep, voffA);
            PG8_WAIT_V(8); PG8_WAIT_L(0); PG8_BAR; PG8_MMA(0, 0, At, B0); PG8_MMA(0, 1, At, B1); PG8_BAR; PG8_SCHED;
            PG8_LDA(At, 0, 1); PG8_STAGE(PG8_SB(0, 0), b2, voffB); PG8_STAGE(PG8_SB(0, 1), b2 + hstep, voffB); PG8_STAGE(PG8_SA(0, 0), a2, voffA);
            PG8_WAIT_V(8); PG8_WAIT_L(0); PG8_BAR; PG8_MMA(1, 0, At, B0); PG8_MMA(1, 1, At, B1); PG8_BAR; PG8_SCHED;
            PG8_LDB(B0, 1, 0); PG8_LDB(B1, 1, 1); PG8_SCHED; PG8_LDA(At, 1, 0); PG8_STAGE(PG8_SA(0, 1), a2 + hstep, voffA);
            PG8_WAIT_V(8); PG8_WAIT_L(0); PG8_BAR; PG8_MMA(0, 0, At, B0); PG8_MMA(0, 1, At, B1); PG8_BAR; PG8_SCHED;
            PG8_LDA(At, 1, 1); PG8_STAGE(PG8_SB(1, 0), b3, voffB); PG8_STAGE(PG8_SB(1, 1), b3 + hstep, voffB); PG8_STAGE(PG8_SA(1, 0), a3, voffA);
            PG8_WAIT_V(8); PG8_WAIT_L(0); PG8_BAR; PG8_MMA(1, 0, At, B0); PG8_MMA(1, 1, At, B1); PG8_BAR; PG8_SCHED;
            } else {
            PG8_LDB(B0, 0, 0); PG8_SCHED; PG8_LDA(At, 0, 0); PG8_STAGE(PG8_SA(1, 1), a1 + hstep, voffA);
            PG8_WAIT_L(8); PG8_BAR; PG8_WAIT_L(0); PG8_MMA(0, 0, At, B0); PG8_BAR; PG8_SCHED;
            PG8_LDB(B1, 0, 1); PG8_STAGE(PG8_SB(0, 0), b2, voffB);
            PG8_BAR; PG8_WAIT_L(0); PG8_MMA(0, 1, At, B1); PG8_BAR;
            PG8_LDA(At, 0, 1); PG8_STAGE(PG8_SA(0, 0), a2, voffA);
            PG8_BAR; PG8_WAIT_L(0); PG8_MMA(1, 0, At, B0); PG8_BAR; PG8_SCHED;
            PG8_STAGE(PG8_SB(0, 1), b2 + hstep, voffB);
            PG8_WAIT_V(6); PG8_BAR; PG8_MMA(1, 1, At, B1); PG8_BAR;
            PG8_LDB(B0, 1, 0); PG8_SCHED; PG8_LDA(At, 1, 0); PG8_STAGE(PG8_SA(0, 1), a2 + hstep, voffA);
            PG8_WAIT_L(8); PG8_BAR; PG8_WAIT_L(0); PG8_MMA(0, 0, At, B0); PG8_BAR; PG8_SCHED;
            PG8_LDB(B1, 1, 1); PG8_STAGE(PG8_SB(1, 0), b3, voffB);
            PG8_BAR; PG8_WAIT_L(0); PG8_MMA(0, 1, At, B1); PG8_BAR;
            PG8_LDA(At, 1, 1); PG8_STAGE(PG8_SA(1, 0), a3, voffA);
            PG8_BAR; PG8_WAIT_L(0); PG8_MMA(1, 0, At, B0); PG8_BAR; PG8_SCHED;
            PG8_STAGE(PG8_SB(1, 1), b3 + hstep, voffB);
            PG8_WAIT_V(6); PG8_BAR; PG8_MMA(1, 1, At, B1); PG8_BAR;
            }
        }
        if constexpr (ALIGN_EPI) { if (wr == 0) PG8_BAR; }
        if constexpr (!Epi::AFTER_DRAIN) { E(acc, cur, wr, wc, fr, fq); S.done(cur); }
        if (!has_next) break;
#pragma unroll
        for (int a = 0; a < 2; ++a)
#pragma unroll
            for (int b = 0; b < 2; ++b)
#pragma unroll
                for (int m = 0; m < 4; ++m)
#pragma unroll
                    for (int n = 0; n < 2; ++n) acc[a][b][m][n] = (f32x4){0.f, 0.f, 0.f, 0.f};
        cur = nxt; cA = nA; cB = nB; ++ui;
        if constexpr (ALIGN_EPI) { if (wr == 1) PG8_BAR; }
    }
    PG8_WAIT_V(0);
    if constexpr (!ALIGN_EPI) { if (wr == 0) PG8_BAR; }
    PG8_BAR;
    if constexpr (Epi::AFTER_DRAIN) { E.fused(acc, cur, wr, wc, fr, fq, lds, wid, lane); S.done(cur); }
#undef PG8_SA
#undef PG8_SB
#undef PG8_STAGE
#undef PG8_LDA
#undef PG8_LDB
#undef PG8_MMA
#undef PG8_WAIT_V
#undef PG8_WAIT_L
#undef PG8_BAR
#undef PG8_SCHED
}
}
#define LAS __attribute__((address_space(3)))
using pg8::silu_f;
typedef unsigned short bf16_t;
typedef float f32x4 __attribute__((ext_vector_type(4)));
typedef float f32x2 __attribute__((ext_vector_type(2)));
typedef unsigned u32x4 __attribute__((ext_vector_type(4)));
typedef unsigned u32x2 __attribute__((ext_vector_type(2)));
constexpr int D = 1024, NB = 8, SEQ = 2048, MP = NB * SEQ, NS = 32, PIN = 4104, NH = 4096;
constexpr int NPAGES = 64, PAGE = 128;
constexpr int O_Y = 0, O_YS = 16777216, O_KP = 16809984, O_VP = 25198592, O_SP = 33587200, O_CP = 34111488, O_KS = 34148352, O_VS = 34164736, O_SS = 34181120, O_CS = 36278272, O_END = 36425728;
constexpr size_t MiB = 1u << 20;
constexpr size_t WS_CTL = 0, CTL_ZERO_BYTES = 1 * MiB;
constexpr size_t WS_WTIN = 1 * MiB, WS_WTOUT = 9 * MiB, WS_ROPE = 11 * MiB, WS_BETA = 12 * MiB, WS_G = 13 * MiB, WS_HSP = 14 * MiB  ;
constexpr size_t WS_QS = 20 * MiB  , WS_GSA = 21 * MiB  , WS_MIXS = 22 * MiB  ;
constexpr size_t WS_XB = 32 * MiB, WS_H = 64 * MiB, WS_OA = 192 * MiB, WS_OB = 224 * MiB, WS_MIXIN = 256 * MiB, WS_MIX = 296 * MiB, WS_PART = 368 * MiB, WS_SCAN = 400 * MiB, WS_U = 456 * MiB, WS_DL = 488 * MiB, WS_END = 489 * MiB;
constexpr int CW_BAR = 4096;
constexpr int LDS_BYTES = 147456;
constexpr int MISC_OFF = 131072 + 320;
constexpr float LAM_INIT = 0.2f;

struct Params {
    const float *x_prompt, *x_sample, *cache_k, *cache_v; const int* page_table; const float *state_delta, *state_conv, *w_in, *conv_w, *a_log, *dt_bias, *delta_norm_w, *diff_lambda, *diff_norm_w, *w_out, *ln_g, *ln_b;
    float* out; unsigned char* ws; int ph_lo, ph_hi;
};
__device__ __forceinline__ float bf2f(bf16_t b) { return __uint_as_float(((unsigned)b) << 16); }
__device__ __forceinline__ unsigned f2bf(float f) { unsigned u = __float_as_uint(f); return (u + 0x7fffu + ((u >> 16) & 1u)) >> 16; }
__device__ __forceinline__ unsigned pk2(float lo, float hi) { return f2bf(lo) | (f2bf(hi) << 16); }
__device__ __forceinline__ float wave_sum(float v) {
#pragma unroll
    for (int o = 1; o < 64; o <<= 1) v += __shfl_xor(v, o);
    return v;
}
__device__ __forceinline__ unsigned pk2f(float lo, float hi) { typedef float f2_ __attribute__((ext_vector_type(2))); typedef __bf16 b2_ __attribute__((ext_vector_type(2))); f2_ v = {lo, hi}; b2_ b = __builtin_convertvector(v, b2_); return __builtin_bit_cast(unsigned, b); }
#define LDS_WAIT() asm volatile("s_waitcnt lgkmcnt(0)" ::: "memory")
#define XB_TMO      128
#define XB_XCNT(j)  (256  + 64 * (j))
#define XB_XSUB(j)  (1280 + 64 * (j))
#define XB_XGEN(j)  (2304 + 64 * (j))
#define XB_TOP      3328
#define XB_TOPGEN   3392
#define XCD_BAR_WORDS 3456
#define XB_SPIN_CAP (1u << 18)
__device__ __forceinline__ unsigned xb_ld(unsigned* p)              { return __hip_atomic_load(p, __ATOMIC_RELAXED, __HIP_MEMORY_SCOPE_AGENT); }
__device__ __forceinline__ unsigned xb_add(unsigned* p, unsigned v) { return __hip_atomic_fetch_add(p, v, __ATOMIC_RELAXED, __HIP_MEMORY_SCOPE_AGENT); }
__device__ __forceinline__ unsigned xb_xcc_id() { return (unsigned)__builtin_amdgcn_s_getreg((3 << 11) | 20) & 0xFu; }
#define XB_SPIN(cond, bar) do { unsigned _sp = 0; while (cond) { __builtin_amdgcn_s_sleep(1); \
    if ((++_sp & 255u) == 0u) { if (xb_ld(&(bar)[XB_TMO])) break; if (_sp > XB_SPIN_CAP) { atomicAdd(&(bar)[XB_TMO], 1u); break; } } } } while (0)

struct XcdBarrier {
    unsigned* bar; unsigned x;
    volatile LAS unsigned* st;
};

__device__ __forceinline__ XcdBarrier xcd_barrier_post(unsigned* bar, volatile LAS unsigned* st) {
    XcdBarrier b; b.bar = bar; b.x = xb_xcc_id(); b.st = st;
    if (threadIdx.x == 0) (void)xb_add(&bar[XB_XCNT(b.x)], 1u);
    return b;
}
__device__ __forceinline__ void xcd_barrier_complete(unsigned* bar, unsigned x, unsigned& nloc, unsigned& nx) {
    const unsigned G = gridDim.x * gridDim.y * gridDim.z;
    unsigned sum, cnt, mine, sp = 0u;
    for (;;) {
        sum = 0u; cnt = 0u; mine = 0u;
#pragma unroll
        for (unsigned j = 0; j < 16; ++j) { const unsigned c = xb_ld(&bar[XB_XCNT(j)]); sum += c; cnt += (c > 0u) ? 1u : 0u; mine = (j == x) ? c : mine; }
        if (sum == G) break;
        __builtin_amdgcn_s_sleep(1);
        if ((++sp & 255u) == 0u) { if (xb_ld(&bar[XB_TMO])) break; if (sp > XB_SPIN_CAP) { atomicAdd(&bar[XB_TMO], 1u); break; } }
    }
    nloc = mine > 0u ? mine : 1u; nx = cnt > 0u ? cnt : 1u;
}

__device__ __forceinline__ void xcd_barrier(const XcdBarrier& b) {
    asm volatile("s_waitcnt vmcnt(0)" ::: "memory");
    __syncthreads();
    if (threadIdx.x == 0) {
        unsigned* bar = b.bar;
        __builtin_amdgcn_s_waitcnt(0);
        unsigned nloc = b.st[0], nx = b.st[1];
        if (nloc == 0u) { xcd_barrier_complete(bar, b.x, nloc, nx); b.st[0] = nloc; b.st[1] = nx; }
        const unsigned old = xb_add(&bar[XB_XSUB(b.x)], 1u);
        const unsigned gen = old / nloc;
        if (old + 1u == (gen + 1u) * nloc) {
            __builtin_amdgcn_fence(__ATOMIC_RELEASE, "agent");
            asm volatile("s_waitcnt vmcnt(0)" ::: "memory");
            const unsigned og = xb_add(&bar[XB_TOP], 1u);
            const unsigned tg = og / nx;
            if (og + 1u == (tg + 1u) * nx) xb_add(&bar[XB_TOPGEN], 1u);
            else XB_SPIN(xb_ld(&bar[XB_TOPGEN]) == tg, bar);
            __builtin_amdgcn_fence(__ATOMIC_ACQUIRE, "agent");
            xb_add(&bar[XB_XGEN(b.x)], 1u);
            asm volatile("s_waitcnt vmcnt(0)" ::: "memory");
        } else {
            XB_SPIN(xb_ld(&bar[XB_XGEN(b.x)]) == gen, bar);
            __builtin_amdgcn_fence(__ATOMIC_ACQUIRE, "agent");
            asm volatile("s_waitcnt vmcnt(0)" ::: "memory");
        }
    }
    __syncthreads();
}
__device__ __forceinline__ void p0_transpose_item(const float* W, int K, int ldw, int N, bf16_t* WT, LAS float* scr, int item, int lane, bool permq) {
    const int nblk = N / 32, kb = item / nblk, nb = item % nblk, k0 = 64 * kb, n0 = 32 * nb;
    int sc = lane & 31;
    if (permq && n0 < 1024 && (n0 & 32) == 0 && sc < 16) sc = (sc >> 1) + 8 * (sc & 1);
#pragma unroll 8
    for (int i = 0; i < 32; ++i) { const int kk = 2 * i + (lane >> 5); scr[kk * 33 + (lane & 31)] = W[(size_t)(k0 + kk) * ldw + n0 + sc]; }
    LDS_WAIT(); asm volatile("" ::: "memory");
    const int c = lane & 7;
#pragma unroll
    for (int j = 0; j < 4; ++j) { const int n = (lane >> 3) + 8 * j; const LAS float* s = scr + (8 * c) * 33 + n;
        u32x4 o; o.x = pk2(s[0 * 33], s[1 * 33]); o.y = pk2(s[2 * 33], s[3 * 33]); o.z = pk2(s[4 * 33], s[5 * 33]); o.w = pk2(s[6 * 33], s[7 * 33]);
        *(u32x4*)(WT + (size_t)(n0 + n) * K + k0 + 8 * c) = o; }
    LDS_WAIT(); asm volatile("" ::: "memory");
}
__device__ __forceinline__ void ph_prologue(const Params& p, LAS unsigned char* lds, int bid, int nblk) {
    const int tid = threadIdx.x, lane = tid & 63, wave = tid >> 6;
    const int gw = bid * 8 + wave, ngw = nblk * 8;
    bf16_t* WTI = (bf16_t*)(p.ws + WS_WTIN); bf16_t* WTO = (bf16_t*)(p.ws + WS_WTOUT);
    { LAS float* scr = (LAS float*)(lds + wave * 8704);
      constexpr int I_IN = 16 * 128, I_OUT = 16 * 32;
      for (int it = gw; it < I_IN + I_OUT; it += ngw) {
          if (it < I_IN) p0_transpose_item(p.w_in, 1024, PIN, 4096, WTI, scr, it, lane, true);
          else p0_transpose_item(p.w_out, 1024, 1024, 1024, WTO, scr, it - I_IN, lane, false);
      } }
    LAS float* wb = (LAS float*)(lds + 69632);
    for (int i = tid; i < 8192; i += 512) wb[i] = p.w_in[(size_t)(i >> 3) * PIN + 4096 + (i & 7)];
    __syncthreads();
    { bf16_t* XB = (bf16_t*)(p.ws + WS_XB); float* BETA = (float*)(p.ws + WS_BETA); float* GG = (float*)(p.ws + WS_G);
      for (int row = gw; row < MP + NS; row += ngw) {
          const float* src = row < MP ? p.x_prompt + (size_t)row * D : p.x_sample + (size_t)(row - MP) * D;
          f32x4 v[4]; float acc[8];
#pragma unroll
          for (int c = 0; c < 8; ++c) acc[c] = 0.f;
#pragma unroll
          for (int j = 0; j < 4; ++j) v[j] = *(const f32x4*)(src + 4 * lane + 256 * j);
          if (row < MP) {
#pragma unroll
              for (int j = 0; j < 4; ++j) { u32x2 w; w.x = pk2(v[j][0], v[j][1]); w.y = pk2(v[j][2], v[j][3]); *(u32x2*)(XB + (size_t)row * D + 4 * lane + 256 * j) = w; } }
#pragma unroll
          for (int j = 0; j < 4; ++j)
#pragma unroll
              for (int e = 0; e < 4; ++e) { const int k = 256 * j + 4 * lane + e; const f32x4 w0 = *(const LAS f32x4*)(wb + k * 8), w1 = *(const LAS f32x4*)(wb + k * 8 + 4); const float xv = v[j][e];
                  acc[0] += xv * w0[0]; acc[1] += xv * w0[1]; acc[2] += xv * w0[2]; acc[3] += xv * w0[3]; acc[4] += xv * w1[0]; acc[5] += xv * w1[1]; acc[6] += xv * w1[2]; acc[7] += xv * w1[3]; }
#pragma unroll
          for (int c = 0; c < 8; ++c) acc[c] = wave_sum(acc[c]);
          float s = acc[0];
#pragma unroll
          for (int c = 1; c < 8; ++c) s = (lane == c) ? acc[c] : s;
          if (lane < 4) BETA[(size_t)row * 4 + lane] = 1.f / (1.f + expf(-s));
          else if (lane < 8) { const int h = lane - 4; const float xx = s + p.dt_bias[h]; const float sp = xx > 20.f ? xx : log1pf(expf(xx)); GG[(size_t)row * 4 + h] = -expf(p.a_log[h]) * sp; }
      } }
    { float* RT = (float*)(p.ws + WS_ROPE);
      for (int i = bid * 512 + tid; i < 2049 * 8; i += nblk * 512) { const int pi = i >> 3, f = i & 7; const float pos = pi < 2048 ? (float)pi : 8192.f;
          const float inv = (float)pow(500000.0, -(double)f / 8.0); const float ang = pos * inv; RT[2 * i] = (float)cos((double)ang); RT[2 * i + 1] = (float)sin((double)ang); } }
    { float* HSP = (float*)(p.ws + WS_HSP); LAS float* xs = (LAS float*)(lds + 102400);
      for (int item = bid; item < 72; item += nblk) { const int ks = item / 9, cb = item % 9, col = cb * 512 + tid;
          __syncthreads();
          for (int i = tid; i < 4096; i += 512) xs[i] = p.x_sample[(size_t)(i >> 7) * D + ks * 128 + (i & 127)];
          __syncthreads();
          if (col < PIN) { float acc[32];
#pragma unroll
              for (int r = 0; r < 32; ++r) acc[r] = 0.f;
              for (int kk = 0; kk < 128; kk += 4) { const float* wp = p.w_in + (size_t)(ks * 128 + kk) * PIN + col; const float w0 = wp[0], w1 = wp[PIN], w2 = wp[2 * PIN], w3 = wp[3 * PIN];
#pragma unroll
                  for (int r = 0; r < 32; ++r) { const f32x4 x4 = *(const LAS f32x4*)(xs + r * 128 + kk); acc[r] += x4[0] * w0 + x4[1] * w1 + x4[2] * w2 + x4[3] * w3; } }
#pragma unroll
              for (int r = 0; r < 32; ++r) HSP[(size_t)(ks * 32 + r) * PIN + col] = acc[r]; }
      } }
}
__device__ __forceinline__ void ph_sample_post(const Params& p, LAS unsigned char* lds, int bid, int nblk) {
    const int tid = threadIdx.x, t = tid & 127, cat = tid >> 7;
    LAS float* raw = (LAS float*)lds;
    LAS float* cv3 = raw + 1024;
    LAS float* gzb = cv3 + 384;
    LAS float* red = gzb + 128;
    LAS float* red2 = red + 512;
    LAS float* ov = red2 + 512;
    const float* HSP = (const float*)(p.ws + WS_HSP); const float* RT = (const float*)(p.ws + WS_ROPE) + 2048 * 16;
    float* QS = (float*)(p.ws + WS_QS); float* GSA = (float*)(p.ws + WS_GSA);
    const float* BETA = (const float*)(p.ws + WS_BETA); const float* GG = (const float*)(p.ws + WS_G);
    bf16_t* MIXIN = (bf16_t*)(p.ws + WS_MIXIN);
    for (int u = bid; u < NS * 4; u += nblk) {
        const int b = u >> 2, h = u & 3;
        __syncthreads();
        { const int col1 = cat * 512 + h * 128 + t, col2 = (cat + 4) * 512 + h * 128 + t; float s1 = 0.f, s2 = 0.f;
          for (int ks = 0; ks < 8; ++ks) { s1 += HSP[(size_t)(ks * 32 + b) * PIN + col1]; s2 += HSP[(size_t)(ks * 32 + b) * PIN + col2]; }
          raw[cat * 128 + t] = s1; raw[(cat + 4) * 128 + t] = s2; }
        __syncthreads();
        {
            const float x = raw[cat * 128 + t]; const int d = t & 63;
            if (cat <= 1) { float o = x;
                if (d < 8) { const float x2 = raw[cat * 128 + t + 8]; o = x * RT[2 * d] - x2 * RT[2 * d + 1]; }
                else if (d < 16) { const float x1 = raw[cat * 128 + t - 8]; const int f = d - 8; o = x * RT[2 * f] + x1 * RT[2 * f + 1]; }
                if (cat == 0) QS[b * 512 + h * 128 + t] = o * 0.125f; else p.out[O_KS + b * 512 + h * 128 + t] = o; }
            else if (cat == 2) p.out[O_VS + b * 512 + h * 128 + t] = x;
            else GSA[b * 512 + h * 128 + t] = silu_f(x);
            const float y = raw[(cat + 4) * 128 + t];
            if (cat < 3) { const int ch = cat * 512 + h * 128 + t; const float* sc = p.state_conv + (size_t)b * 3 * 1536 + ch;
                const float s0 = sc[0], s1 = sc[1536], s2 = sc[3072];
                const float val = s0 * p.conv_w[ch] + s1 * p.conv_w[1536 + ch] + s2 * p.conv_w[3072 + ch] + y * p.conv_w[4608 + ch];
                cv3[cat * 128 + t] = silu_f(val);
                float* co = p.out + O_CS + (size_t)b * 3 * 1536 + ch; co[0] = s1; co[1536] = s2; co[3072] = y; }
            else gzb[t] = silu_f(y);
        }
        __syncthreads();
        float sq = 0.f, sk = 0.f;
        for (int i = 0; i < 128; ++i) { const float a = cv3[i], c = cv3[128 + i]; sq += a * a; sk += c * c; }
        const float nq = rsqrtf(sq + 1e-6f) * 0.08838834764831845f, nk = rsqrtf(sk + 1e-6f);
        const float beta = BETA[(size_t)(MP + b) * 4 + h], eg = expf(GG[(size_t)(MP + b) * 4 + h]);
        const int dv = t, g4 = cat;
        float S[32]; const float* S0 = p.state_delta + ((size_t)(b * 4 + h) * 128 + g4 * 32) * 128 + dv;
        float part = 0.f;
#pragma unroll
        for (int i = 0; i < 32; ++i) { S[i] = S0[(size_t)i * 128]; part += S[i] * cv3[128 + g4 * 32 + i]; }
        red[g4 * 128 + dv] = part;
        __syncthreads();
        const float r = (red[dv] + red[128 + dv] + red[256 + dv] + red[384 + dv]) * nk;
        const float vnew = beta * (cv3[256 + dv] - eg * r);
        float part2 = 0.f; float* S1 = p.out + O_SS + ((size_t)(b * 4 + h) * 128 + g4 * 32) * 128 + dv;
#pragma unroll
        for (int i = 0; i < 32; ++i) { S[i] = eg * S[i] + (cv3[128 + g4 * 32 + i] * nk) * vnew; S1[(size_t)i * 128] = S[i]; part2 += S[i] * cv3[g4 * 32 + i]; }
        red2[g4 * 128 + dv] = part2;
        __syncthreads();
        const float o = (red2[dv] + red2[128 + dv] + red2[256 + dv] + red2[384 + dv]) * nq;
        if (g4 == 0) ov[dv] = o;
        __syncthreads();
        if (g4 == 0) { float ss = 0.f; for (int i = 0; i < 128; ++i) ss += ov[i] * ov[i];
            const float rn = rsqrtf(ss * (1.f / 128.f) + 1e-6f);
            MIXIN[(size_t)(MP + b) * D + 512 + h * 128 + dv] = (bf16_t)f2bf(o * rn * p.delta_norm_w[dv] * gzb[dv]); }
    }
}
typedef short bf16x8v __attribute__((ext_vector_type(8)));
typedef short s16x4v __attribute__((ext_vector_type(4)));
typedef float f32x16 __attribute__((ext_vector_type(16)));
__device__ __forceinline__ int crow16(int r, int hi) { return (r & 3) + 8 * (r >> 2) + 4 * hi; }
__device__ __forceinline__ int perm32pos(int a) { return 8 * ((a >> 2) & 3) + 4 * (a >> 4) + (a & 3); }
constexpr int SC_WN = 0, SC_QG = 16384, SC_KGT = 32768, SC_ATT = 49152, SC_UNIT = 57344;
__device__ __forceinline__ s16x4v lds_tr16(LAS const unsigned char* p) { return __builtin_bit_cast(s16x4v, __builtin_amdgcn_ds_read_tr16_b64_v4i16((LAS s16x4v*)p)); }
#ifndef PSKIP
#define PSKIP 0
#endif
__device__ __forceinline__ void ph_delta_prep(const Params& p, LAS unsigned char* lds, int bid, int nblk, int rep = 0) {
    const int tid0 = threadIdx.x, wave = __builtin_amdgcn_readfirstlane(tid0 >> 6);
    LAS unsigned char* QN = lds; LAS unsigned char* KN = lds + 16384; LAS unsigned char* VBT = lds + 32768; LAS unsigned char* KBG = lds + 49152;
    LAS float* AM = (LAS float*)(lds + 65536)  ; LAS unsigned char* TB = lds + 82944  ; LAS unsigned char* XS = lds + 91136  ; LAS float* GCS = (LAS float*)(lds + 95232); LAS float* EGC = GCS + 64; LAS float* BET = GCS + 128;
    const bf16_t* H = (const bf16_t*)(p.ws + WS_H); const float* BETA = (const float*)(p.ws + WS_BETA); const float* GG = (const float*)(p.ws + WS_G);
    unsigned char* SCAN = p.ws + WS_SCAN + (size_t)rep * (128u << 20); float* UG = (float*)(p.ws + WS_U + (size_t)rep * (128u << 20)); float* DLG = (float*)(p.ws + WS_DL + (size_t)rep * (128u << 20));
    for (int u = bid; u < 1024; u += nblk) {
        const int n = u & 31, bh = u >> 5, b = bh >> 2, h = bh & 3; const size_t rowc = (size_t)b * SEQ + n * 64;
        int tid = tid0; asm volatile("" : "+v"(tid));
        const int lane = tid & 63;
        __syncthreads();
        float gc;
        const float betal = BETA[(rowc + lane) * 4 + h];
        { float x = GG[(rowc + lane) * 4 + h];
#pragma unroll
          for (int o = 1; o < 64; o <<= 1) { const float y = __shfl_up(x, o); if (lane >= o) x += y; }
          gc = x; }
        const float gcl = __shfl(gc, 63);
        if (wave == 0) { GCS[lane] = gc; EGC[lane] = __expf(gc); BET[lane] = betal; if (lane == 0) DLG[u] = __expf(gcl); }
        {
            float cw[4][3][2];
#pragma unroll
            for (int j = 0; j < 4; ++j)
#pragma unroll
                for (int w3 = 0; w3 < 3; ++w3) { const f32x2 c2 = *(const f32x2*)(p.conv_w + j * 1536 + w3 * 512 + h * 128 + 2 * lane); cw[j][w3][0] = c2[0]; cw[j][w3][1] = c2[1]; }
            float xin[11][3][2];
#pragma unroll
            for (int rr = 0; rr < 11; ++rr) { const int tt = n * 64 + wave * 8 - 3 + rr;
#pragma unroll
                for (int w3 = 0; w3 < 3; ++w3) { unsigned v = 0u; if (tt >= 0) v = *(const unsigned*)(H + ((size_t)b * SEQ + tt) * 4096 + 2048 + w3 * 512 + h * 128 + 2 * lane);
                    xin[rr][w3][0] = __uint_as_float(v << 16); xin[rr][w3][1] = __uint_as_float(v & 0xffff0000u); } }
            if (!(rep == 1 && (PSKIP & 1)))
#pragma unroll
            for (int i = 0; i < 8; ++i) { const int tt = wave * 8 + i; float val[3][2];
#pragma unroll
                for (int w3 = 0; w3 < 3; ++w3)
#pragma unroll
                    for (int e = 0; e < 2; ++e) val[w3][e] = silu_f(xin[i][w3][e] * cw[0][w3][e] + xin[i + 1][w3][e] * cw[1][w3][e] + xin[i + 2][w3][e] * cw[2][w3][e] + xin[i + 3][w3][e] * cw[3][w3][e]);
                const float nq = rsqrtf(wave_sum(val[0][0] * val[0][0] + val[0][1] * val[0][1]) + 1e-6f) * 0.08838834764831845f;
                const float nk = rsqrtf(wave_sum(val[1][0] * val[1][0] + val[1][1] * val[1][1]) + 1e-6f);
                const float bt = __shfl(betal, tt), egt = __expf(__shfl(gc, tt));
                const int d = 2 * lane, sw = (((d >> 3) ^ (tt & 15)) * 16) + (d & 7) * 2;
                *(LAS unsigned*)(QN + tt * 256 + sw) = pk2(val[0][0] * nq, val[0][1] * nq);
                *(LAS unsigned*)(KN + tt * 256 + sw) = pk2(val[1][0] * nk, val[1][1] * nk);
                const int tro = (d >> 5) * 4096 + tt * 64 + (d & 31) * 2;
                *(LAS unsigned*)(VBT + tro) = pk2(val[2][0] * bt, val[2][1] * bt);
                *(LAS unsigned*)(KBG + tro) = pk2(val[1][0] * nk * bt * egt, val[1][1] * nk * bt * egt);
            }
        }
        __syncthreads();
        if (!(rep == 1 && (PSKIP & 8))) { const int which = wave >> 2, ti = (wave >> 1) & 1, tj = wave & 1, r32 = lane & 31, hh = lane >> 5;
          const int ra = 32 * ti + r32, rb = 32 * tj + r32; LAS const unsigned char* Ab = which ? QN : KN;
          f32x16 acc = {0.f, 0.f, 0.f, 0.f, 0.f, 0.f, 0.f, 0.f, 0.f, 0.f, 0.f, 0.f, 0.f, 0.f, 0.f, 0.f};
#pragma unroll
          for (int s = 0; s < 8; ++s) { const bf16x8v a = *(LAS const bf16x8v*)(Ab + ra * 256 + (((2 * s + hh) ^ (ra & 15)) * 16)), bb = *(LAS const bf16x8v*)(KN + rb * 256 + (((2 * s + hh) ^ (rb & 15)) * 16));
              acc = __builtin_amdgcn_mfma_f32_32x32x16_bf16(a, bb, acc, 0, 0, 0); }
          const int j = 32 * tj + r32; const float gcj = GCS[j];
          unsigned char* attg = SCAN + (size_t)u * SC_UNIT + SC_ATT; const int posj = 32 * (j >> 5) + perm32pos(j & 31);
#pragma unroll
          for (int r = 0; r < 16; ++r) { const int i = 32 * ti + crow16(r, hh); const float dec = (i >= j) ? __expf(GCS[i] - gcj) : 0.f;
              if (which == 0) AM[i * 68 + j] = (i > j) ? BET[i] * acc[r] * dec : 0.f;
              else *(bf16_t*)(attg + i * 128 + (((posj >> 3) ^ ((i >> 1) & 7)) * 16) + (posj & 7) * 2) = (bf16_t)f2bf(acc[r] * dec); } }
        if (!(rep == 1 && (PSKIP & 16))) { unsigned char* qgg = SCAN + (size_t)u * SC_UNIT + SC_QG; unsigned char* kgg = SCAN + (size_t)u * SC_UNIT + SC_KGT;
#pragma unroll
          for (int k2 = 0; k2 < 2; ++k2) { const int job = tid + 512 * k2;
              { const int t = job >> 4, pp = job & 15, s = pp >> 2, kq = pp & 3, da = 32 * s + 4 * kq, db = da + 16; const float eg = EGC[t];
                const u32x2 xa = *(LAS const u32x2*)(QN + t * 256 + (((da >> 3) ^ (t & 15)) * 16) + (da & 7) * 2), xb = *(LAS const u32x2*)(QN + t * 256 + (((db >> 3) ^ (t & 15)) * 16) + (db & 7) * 2);
                u32x4 o; o.x = pk2(__uint_as_float(xa.x << 16) * eg, __uint_as_float(xa.x & 0xffff0000u) * eg); o.y = pk2(__uint_as_float(xa.y << 16) * eg, __uint_as_float(xa.y & 0xffff0000u) * eg);
                o.z = pk2(__uint_as_float(xb.x << 16) * eg, __uint_as_float(xb.x & 0xffff0000u) * eg); o.w = pk2(__uint_as_float(xb.y << 16) * eg, __uint_as_float(xb.y & 0xffff0000u) * eg);
                *(u32x4*)(qgg + t * 256 + ((pp ^ (t & 15)) * 16)) = o; }
              { const int dk = job >> 3, pp = job & 7, s = pp >> 2, kq = pp & 3; float v8[8];
#pragma unroll
                for (int jj = 0; jj < 8; ++jj) { const int t = 32 * s + 16 * (jj >> 2) + 4 * kq + (jj & 3);
                    v8[jj] = bf2f(*(LAS const bf16_t*)(KN + t * 256 + (((dk >> 3) ^ (t & 15)) * 16) + (dk & 7) * 2)) * __expf(gcl - GCS[t]); }
                u32x4 o; o.x = pk2(v8[0], v8[1]); o.y = pk2(v8[2], v8[3]); o.z = pk2(v8[4], v8[5]); o.w = pk2(v8[6], v8[7]);
                *(u32x4*)(kgg + dk * 128 + ((pp ^ ((dk >> 1) & 7)) * 16)) = o; } } }
        __syncthreads();
#define TBADDR(base, row, col) ((base) + (row) * 128 + ((((col) >> 3) ^ (((row) >> 1) & 7)) * 16) + ((col) & 7) * 2)
        if (wave == 0 && !(rep == 1 && (PSKIP & 2))) {
            const int blk = lane >> 4, c = lane & 15, r32 = lane & 31, hh = lane >> 5, trr = (lane & 15) >> 2, trc = 16 * ((lane >> 4) & 1) + 4 * (lane & 3);
#pragma unroll
            for (int bi = 0; bi < 3; ++bi) if (bi < blk) {
#pragma unroll
                for (int i = 0; i < 16; ++i) *(LAS bf16_t*)TBADDR(TB, 16 * bi + i, 16 * blk + c) = (bf16_t)0; }
            { float tt[16]; LAS const float* rp = AM + (16 * blk) * 68 + 16 * blk;
#pragma unroll
              for (int i = 0; i < 16; ++i) { float a = (i == c) ? 1.f : 0.f;
#pragma unroll
                  for (int j0 = 0; j0 < i; j0 += 4) { const f32x4 av = *(LAS const f32x4*)(rp + i * 68 + j0);
#pragma unroll
                      for (int jj = 0; jj < 4; ++jj) if (j0 + jj < i) a -= av[jj] * tt[j0 + jj]; }
                  tt[i] = a; }
#pragma unroll
              for (int i = 0; i < 16; ++i) *(LAS bf16_t*)TBADDR(TB, 16 * blk + i, 16 * blk + c) = (bf16_t)f2bf(tt[i]); }
            LDS_WAIT();
            const f32x16 zero16 = {0.f, 0.f, 0.f, 0.f, 0.f, 0.f, 0.f, 0.f, 0.f, 0.f, 0.f, 0.f, 0.f, 0.f, 0.f, 0.f};
#pragma unroll
            for (int pb = 0; pb < 4; pb += 2) { const int lo = pb, hb = pb + 1;
                { LAS const float* ap = AM + (16 * hb + (r32 & 15)) * 68 + 16 * lo + 8 * hh; const f32x4 a0 = *(LAS const f32x4*)ap, a1 = *(LAS const f32x4*)(ap + 4);
                  u32x4 aw; aw.x = pk2f(a0[0], a0[1]); aw.y = pk2f(a0[2], a0[3]); aw.z = pk2f(a1[0], a1[1]); aw.w = pk2f(a1[2], a1[3]);
                  const int rb = 16 * lo + 8 * hh + trr, cc = 16 * lo + trc;
                  const s16x4v l4 = lds_tr16(TBADDR(TB, rb, cc)), h4 = lds_tr16(TBADDR(TB, rb + 4, cc)); const bf16x8v bb = {l4[0], l4[1], l4[2], l4[3], h4[0], h4[1], h4[2], h4[3]};
                  const f32x16 x = __builtin_amdgcn_mfma_f32_32x32x16_bf16(__builtin_bit_cast(bf16x8v, aw), bb, zero16, 0, 0, 0);
#pragma unroll
                  for (int r = 0; r < 8; ++r) *(LAS bf16_t*)TBADDR(XS, crow16(r, hh), r32) = (bf16_t)f2bf(x[r]); }
                LDS_WAIT();
                { const int ra = 16 * hb + (r32 & 15); const bf16x8v af = *(LAS const bf16x8v*)(TB + ra * 128 + (((2 * hb + hh) ^ ((ra >> 1) & 7)) * 16));
                  const int rb = 8 * hh + trr;
                  const s16x4v l4 = lds_tr16(TBADDR(XS, rb, trc)), h4 = lds_tr16(TBADDR(XS, rb + 4, trc)); const bf16x8v bb = {l4[0], l4[1], l4[2], l4[3], h4[0], h4[1], h4[2], h4[3]};
                  const f32x16 y = __builtin_amdgcn_mfma_f32_32x32x16_bf16(af, bb, zero16, 0, 0, 0);
                  if (r32 < 16) {
#pragma unroll
                      for (int r = 0; r < 8; ++r) *(LAS bf16_t*)TBADDR(TB, 16 * hb + crow16(r, hh), 16 * lo + r32) = (bf16_t)f2bf(-y[r]); } }
                LDS_WAIT();
            }
            { f32x16 x = zero16;
#pragma unroll
              for (int s2 = 0; s2 < 2; ++s2) { LAS const float* ap = AM + (32 + r32) * 68 + 16 * s2 + 8 * hh; const f32x4 a0 = *(LAS const f32x4*)ap, a1 = *(LAS const f32x4*)(ap + 4);
                  u32x4 aw; aw.x = pk2f(a0[0], a0[1]); aw.y = pk2f(a0[2], a0[3]); aw.z = pk2f(a1[0], a1[1]); aw.w = pk2f(a1[2], a1[3]);
                  const int rb = 16 * s2 + 8 * hh + trr;
                  const s16x4v l4 = lds_tr16(TBADDR(TB, rb, trc)), h4 = lds_tr16(TBADDR(TB, rb + 4, trc)); const bf16x8v bb = {l4[0], l4[1], l4[2], l4[3], h4[0], h4[1], h4[2], h4[3]};
                  x = __builtin_amdgcn_mfma_f32_32x32x16_bf16(__builtin_bit_cast(bf16x8v, aw), bb, x, 0, 0, 0); }
#pragma unroll
              for (int r = 0; r < 16; ++r) *(LAS bf16_t*)TBADDR(XS, crow16(r, hh), r32) = (bf16_t)f2bf(x[r]); }
            LDS_WAIT();
            { f32x16 y = zero16; const int ra = 32 + r32;
#pragma unroll
              for (int s2 = 0; s2 < 2; ++s2) { const bf16x8v af = *(LAS const bf16x8v*)(TB + ra * 128 + (((4 + 2 * s2 + hh) ^ ((ra >> 1) & 7)) * 16));
                  const int rb = 16 * s2 + 8 * hh + trr;
                  const s16x4v l4 = lds_tr16(TBADDR(XS, rb, trc)), h4 = lds_tr16(TBADDR(XS, rb + 4, trc)); const bf16x8v bb = {l4[0], l4[1], l4[2], l4[3], h4[0], h4[1], h4[2], h4[3]};
                  y = __builtin_amdgcn_mfma_f32_32x32x16_bf16(af, bb, y, 0, 0, 0); }
#pragma unroll
              for (int r = 0; r < 16; ++r) *(LAS bf16_t*)TBADDR(TB, 32 + crow16(r, hh), r32) = (bf16_t)f2bf(-y[r]); }
        }
#undef TBADDR
        __syncthreads();
        if (!(rep == 1 && (PSKIP & 4))) { const int sel = wave >> 2, tj = wave & 3, r32 = lane & 31, hh = lane >> 5; LAS const unsigned char* Bb = (sel ? KBG : VBT) + tj * 4096 + ((lane >> 4) & 1) * 32 + (lane & 3) * 8 + (8 * hh + ((lane & 15) >> 2)) * 64;
          unsigned char* wng = SCAN + (size_t)u * SC_UNIT + SC_WN; float* ug = UG + (size_t)u * 8192;
#pragma unroll
          for (int ti = 0; ti < 2; ++ti) { const int ra = 32 * ti + r32;
              f32x16 acc = {0.f, 0.f, 0.f, 0.f, 0.f, 0.f, 0.f, 0.f, 0.f, 0.f, 0.f, 0.f, 0.f, 0.f, 0.f, 0.f};
#pragma unroll
              for (int s = 0; s < 4; ++s) { const bf16x8v a = *(LAS const bf16x8v*)(TB + ra * 128 + (((2 * s + hh) ^ ((ra >> 1) & 7)) * 16));
                  const s16x4v lo = lds_tr16(Bb + s * 1024), hi4 = lds_tr16(Bb + s * 1024 + 256);
                  const bf16x8v bb = {lo[0], lo[1], lo[2], lo[3], hi4[0], hi4[1], hi4[2], hi4[3]};
                  acc = __builtin_amdgcn_mfma_f32_32x32x16_bf16(a, bb, acc, 0, 0, 0); }
              const int e = 32 * tj + r32;
#pragma unroll
              for (int r = 0; r < 16; ++r) { const int t = 32 * ti + crow16(r, hh);
                  if (sel == 0) ug[(((e >> 4) * 4 + (t >> 4)) * 64 + ((t & 15) >> 2) * 16 + (e & 15)) * 4 + (t & 3)] = acc[r];
                  else { const int pos = 32 * (e >> 5) + perm32pos(e & 31); *(bf16_t*)(wng + t * 256 + (((pos >> 3) ^ (t & 15)) * 16) + (pos & 7) * 2) = (bf16_t)f2bf(-acc[r]); } } } }
    }
}
__device__ __forceinline__ void scan_unit(const Params& p, LAS unsigned char* lds, int u, int tid) {
    const int lane = tid & 63, wave = __builtin_amdgcn_readfirstlane(tid >> 6), r16 = lane & 15, kq = lane >> 4;
    const unsigned char* SCAN = p.ws + WS_SCAN; const float* UG = (const float*)(p.ws + WS_U); const float* DLG = (const float*)(p.ws + WS_DL); float* OB = (float*)(p.ws + WS_OB);
    typedef float f32x4v __attribute__((ext_vector_type(4)));
    {
        const int b = u >> 2, h = u & 3; const size_t rowb = (size_t)b * SEQ;
        f32x4v S[8];
#pragma unroll
        for (int i = 0; i < 8; ++i) S[i] = (f32x4v){0.f, 0.f, 0.f, 0.f};
        __syncthreads();
        { const unsigned char* src = SCAN + (size_t)(u * 32) * SC_UNIT;
#pragma unroll
          for (int i = 0; i < 7; ++i) __builtin_amdgcn_global_load_lds((const unsigned*)(src + i * 8192 + wave * 1024 + lane * 16), (LAS unsigned*)(lds + i * 8192 + wave * 1024), 16, 0, 0); }
        asm volatile("s_waitcnt vmcnt(0)" ::: "memory"); __syncthreads();
        for (int n = 0; n < 32; ++n) {
            LAS const unsigned char* buf = lds + (n & 1) * SC_UNIT;
            if (n + 1 < 32) { const unsigned char* src = SCAN + (size_t)(u * 32 + n + 1) * SC_UNIT; LAS unsigned char* dst = lds + ((n + 1) & 1) * SC_UNIT;
#pragma unroll
                for (int i = 0; i < 7; ++i) __builtin_amdgcn_global_load_lds((const unsigned*)(src + i * 8192 + wave * 1024 + lane * 16), (LAS unsigned*)(dst + i * 8192 + wave * 1024), 16, 0, 0); }
            const float* ug = UG + (size_t)(u * 32 + n) * 8192 + (size_t)(wave * 4) * 256 + lane * 4;
            f32x4v vn[4];
#pragma unroll
            for (int mt = 0; mt < 4; ++mt) vn[mt] = *(const f32x4v*)(ug + mt * 256);
            const float dl = DLG[u * 32 + n];
            bf16x8v Sb[4];
#pragma unroll
            for (int s = 0; s < 4; ++s) { u32x4 w; w.x = pk2(S[2 * s][0], S[2 * s][1]); w.y = pk2(S[2 * s][2], S[2 * s][3]); w.z = pk2(S[2 * s + 1][0], S[2 * s + 1][1]); w.w = pk2(S[2 * s + 1][2], S[2 * s + 1][3]); Sb[s] = __builtin_bit_cast(bf16x8v, w); }
            f32x4v o[4];
#pragma unroll
            for (int mt = 0; mt < 4; ++mt) { const int t = 16 * mt + r16; o[mt] = (f32x4v){0.f, 0.f, 0.f, 0.f};
#pragma unroll
                for (int s = 0; s < 4; ++s) { const int off = t * 256 + (((4 * s + kq) ^ r16) * 16);
                    const bf16x8v aw = *(LAS const bf16x8v*)(buf + SC_WN + off), aq = *(LAS const bf16x8v*)(buf + SC_QG + off);
                    vn[mt] = __builtin_amdgcn_mfma_f32_16x16x32_bf16(aw, Sb[s], vn[mt], 0, 0, 0);
                    o[mt] = __builtin_amdgcn_mfma_f32_16x16x32_bf16(aq, Sb[s], o[mt], 0, 0, 0); } }
            bf16x8v Vb[2];
#pragma unroll
            for (int s = 0; s < 2; ++s) { u32x4 w; w.x = pk2(vn[2 * s][0], vn[2 * s][1]); w.y = pk2(vn[2 * s][2], vn[2 * s][3]); w.z = pk2(vn[2 * s + 1][0], vn[2 * s + 1][1]); w.w = pk2(vn[2 * s + 1][2], vn[2 * s + 1][3]); Vb[s] = __builtin_bit_cast(bf16x8v, w); }
#pragma unroll
            for (int mt = 0; mt < 4; ++mt) { const int t = 16 * mt + r16;
#pragma unroll
                for (int s = 0; s < 2; ++s) { const bf16x8v aa = *(LAS const bf16x8v*)(buf + SC_ATT + t * 128 + (((4 * s + kq) ^ ((t >> 1) & 7)) * 16)); o[mt] = __builtin_amdgcn_mfma_f32_16x16x32_bf16(aa, Vb[s], o[mt], 0, 0, 0); }
                float* op = OB + (rowb + n * 64 + 16 * mt + 4 * kq) * 512 + h * 128 + wave * 16 + r16;
#pragma unroll
                for (int r = 0; r < 4; ++r) op[(size_t)r * 512] = o[mt][r]; }
#pragma unroll
            for (int i = 0; i < 8; ++i) { const int dk = 16 * i + r16; S[i] = S[i] * dl;
#pragma unroll
                for (int s = 0; s < 2; ++s) { const bf16x8v ak = *(LAS const bf16x8v*)(buf + SC_KGT + dk * 128 + (((4 * s + kq) ^ ((dk >> 1) & 7)) * 16)); S[i] = __builtin_amdgcn_mfma_f32_16x16x32_bf16(ak, Vb[s], S[i], 0, 0, 0); } }
            asm volatile("s_waitcnt vmcnt(0)" ::: "memory"); __syncthreads();
        }
        float* SP = p.out + O_SP + (size_t)(b * 4 + h) * 16384;
#pragma unroll
        for (int i = 0; i < 8; ++i)
#pragma unroll
            for (int r = 0; r < 4; ++r) SP[(size_t)(16 * i + 4 * kq + r) * 128 + wave * 16 + r16] = S[i][r];
    }
}
__device__ __forceinline__ void attn_unit(const bf16_t* __restrict__ H, bf16_t* __restrict__ OA, LAS unsigned char* lds, int b, int c, int qb, int tid) {
    const int lane = tid & 63, wid = __builtin_amdgcn_readfirstlane(tid >> 6), r32 = lane & 31, hi = lane >> 5, h = c >> 1;
    const size_t rowb = (size_t)b * SEQ; const int q0 = qb * 256, NT = (q0 + 256) / 64;
    bf16x8v qr[4];
    { const bf16_t* qp = H + (rowb + q0 + 32 * wid + r32) * 4096 + c * 64 + 8 * hi;
#pragma unroll
      for (int d0 = 0; d0 < 4; ++d0) qr[d0] = *(const bf16x8v*)(qp + 16 * d0); }
    f32x16 o[4];
#pragma unroll
    for (int d0 = 0; d0 < 4; ++d0)
#pragma unroll
        for (int r = 0; r < 16; ++r) o[d0][r] = 0.f;
    float mhat = -INFINITY, lsum = 0.f;
    LAS float* wsf = (LAS float*)(lds + 49152) + wid * 64;
    const bf16_t* ksrc = H + (rowb + lane) * 4096 + 512 + c * 64 + wid * 8;
    const int pi0 = wid * 2, pi1 = wid * 2 + 1;
    const bf16_t* vsrc0 = H + (rowb + 16 * (pi0 & 3) + (lane >> 2)) * 4096 + 1024 + h * 128 + (pi0 >> 2) * 32 + (lane & 3) * 8;
    const bf16_t* vsrc1 = H + (rowb + 16 * (pi1 & 3) + (lane >> 2)) * 4096 + 1024 + h * 128 + (pi1 >> 2) * 32 + (lane & 3) * 8;
    LAS unsigned char* kdst = lds + wid * 1024; LAS unsigned char* vdst0 = lds + 16384 + (pi0 >> 2) * 4096 + (pi0 & 3) * 1024; LAS unsigned char* vdst1 = lds + 16384 + (pi1 >> 2) * 4096 + (pi1 & 3) * 1024;
#define ATT_ISSUE(t, slot) do { const size_t go_ = (size_t)(t) * 64 * 4096; \
        __builtin_amdgcn_global_load_lds((const unsigned*)(ksrc + go_), (LAS unsigned*)(kdst + (slot) * 8192), 16, 0, 0); \
        __builtin_amdgcn_global_load_lds((const unsigned*)(vsrc0 + go_), (LAS unsigned*)(vdst0 + (slot) * 16384), 16, 0, 0); \
        __builtin_amdgcn_global_load_lds((const unsigned*)(vsrc1 + go_), (LAS unsigned*)(vdst1 + (slot) * 16384), 16, 0, 0); } while (0)
    const int vb = ((lane >> 4) & 1) * 32 + (lane & 3) * 8 + (4 * hi + ((lane & 15) >> 2)) * 64;
    __syncthreads();
    ATT_ISSUE(0, 0);
    for (int t = 0; t < NT; ++t) {
        asm volatile("s_waitcnt vmcnt(0)" ::: "memory"); __syncthreads();
        if (t + 1 < NT) ATT_ISSUE(t + 1, (t + 1) & 1);
        LAS const unsigned char* Ks = lds + (t & 1) * 8192; LAS const unsigned char* Vs = lds + 16384 + (t & 1) * 16384 + vb;
        f32x16 p0, p1;
#pragma unroll
        for (int r = 0; r < 16; ++r) { p0[r] = 0.f; p1[r] = 0.f; }
#pragma unroll
        for (int d0 = 0; d0 < 4; ++d0) { const bf16x8v b0 = *(LAS const bf16x8v*)(Ks + (2 * d0 + hi) * 1024 + r32 * 16), b1 = *(LAS const bf16x8v*)(Ks + (2 * d0 + hi) * 1024 + r32 * 16 + 512);
            p0 = __builtin_amdgcn_mfma_f32_32x32x16_bf16(b0, qr[d0], p0, 0, 0, 0); p1 = __builtin_amdgcn_mfma_f32_32x32x16_bf16(b1, qr[d0], p1, 0, 0, 0); }
        if (t >= NT - 4) { const int kb = 64 * (t - (NT - 4)) + 4 * hi, qrel = 32 * wid + r32;
#pragma unroll
            for (int r = 0; r < 16; ++r) { const int kv = kb + (r & 3) + 8 * (r >> 2); if (kv > qrel) p0[r] = -INFINITY; if (kv + 32 > qrel) p1[r] = -INFINITY; } }
        float rm = fmaxf(p0[0], p1[0]);
#pragma unroll
        for (int r = 1; r < 16; ++r) rm = fmaxf(rm, fmaxf(p0[r], p1[r]));
        rm = fmaxf(rm, __shfl_xor(rm, 32));
        if (__any(rm > mhat + 8.f)) {
            const float mnew = (rm > mhat + 8.f) ? rm : mhat, alpha = exp2f(mhat - mnew);
            lsum *= alpha; mhat = mnew;
            if (hi == 0) wsf[r32] = alpha;
            LDS_WAIT();
#pragma unroll
            for (int r = 0; r < 16; ++r) { const float a = wsf[crow16(r, hi)];
#pragma unroll
                for (int d0 = 0; d0 < 4; ++d0) o[d0][r] *= a; }
        }
        float ps = 0.f;
#pragma unroll
        for (int r = 0; r < 16; ++r) { p0[r] = exp2f(p0[r] - mhat); p1[r] = exp2f(p1[r] - mhat); ps += p0[r] + p1[r]; }
        lsum += ps;
        bf16x8v pw[4];
        { u32x4 w; w.x = pk2f(p0[0], p0[1]); w.y = pk2f(p0[2], p0[3]); w.z = pk2f(p0[4], p0[5]); w.w = pk2f(p0[6], p0[7]); pw[0] = __builtin_bit_cast(bf16x8v, w);
          w.x = pk2f(p0[8], p0[9]); w.y = pk2f(p0[10], p0[11]); w.z = pk2f(p0[12], p0[13]); w.w = pk2f(p0[14], p0[15]); pw[1] = __builtin_bit_cast(bf16x8v, w);
          w.x = pk2f(p1[0], p1[1]); w.y = pk2f(p1[2], p1[3]); w.z = pk2f(p1[4], p1[5]); w.w = pk2f(p1[6], p1[7]); pw[2] = __builtin_bit_cast(bf16x8v, w);
          w.x = pk2f(p1[8], p1[9]); w.y = pk2f(p1[10], p1[11]); w.z = pk2f(p1[12], p1[13]); w.w = pk2f(p1[14], p1[15]); pw[3] = __builtin_bit_cast(bf16x8v, w); }
#pragma unroll
        for (int d0 = 0; d0 < 4; ++d0)
#pragma unroll
            for (int ks = 0; ks < 4; ++ks) { const s16x4v lo = lds_tr16(Vs + d0 * 4096 + ks * 1024), hi4 = lds_tr16(Vs + d0 * 4096 + ks * 1024 + 512);
                const bf16x8v bb = {lo[0], lo[1], lo[2], lo[3], hi4[0], hi4[1], hi4[2], hi4[3]};
                o[d0] = __builtin_amdgcn_mfma_f32_32x32x16_bf16(pw[ks], bb, o[d0], 0, 0, 0); }
    }
#undef ATT_ISSUE
    const float ltot = lsum + __shfl_xor(lsum, 32);
    if (hi == 0) wsf[32 + r32] = 1.f / ltot;
    LDS_WAIT();
    bf16_t* op = OA + (rowb + q0 + 32 * wid) * 1024 + c * 128 + r32;
#pragma unroll
    for (int r = 0; r < 16; ++r) { const int qq = crow16(r, hi); const float inv = wsf[32 + qq];
#pragma unroll
        for (int d0 = 0; d0 < 4; ++d0) op[(size_t)qq * 1024 + 32 * d0] = (bf16_t)f2bf(o[d0][r] * inv); }
    LDS_WAIT();
}
__device__ __forceinline__ void attn_pair(const Params& p, LAS unsigned char* lds, int pu, int tid) {
    const bf16_t* H = (const bf16_t*)(p.ws + WS_H); bf16_t* OA = (bf16_t*)(p.ws + WS_OA);
    const int bc = pu >> 2, s = pu & 3;
    attn_unit(H, OA, lds, bc >> 3, bc & 7, 7 - s, tid);
    asm volatile("" : "+v"(tid));
    attn_unit(H, OA, lds, bc >> 3, bc & 7, s, tid);
}
__device__ __forceinline__ void decode_wave_unit(const Params& p, LAS unsigned char* lds, int wu, int tid) {
    const int lane = tid & 63, wave = __builtin_amdgcn_readfirstlane(tid >> 6);
    LAS float* sc = (LAS float*)(lds + wave * 4096);
    const float* QS = (const float*)(p.ws + WS_QS); float* PART = (float*)(p.ws + WS_PART);
    {
        const int b = wu >> 6;
        const int phys = p.page_table[wu];
        const float* kb = p.cache_k + (size_t)phys * (PAGE * 512); const float* vb = p.cache_v + (size_t)phys * (PAGE * 512);
        const f32x4 q0 = *(const f32x4*)(QS + b * 512 + 4 * lane), q1 = *(const f32x4*)(QS + b * 512 + 256 + 4 * lane);
        for (int t0 = 0; t0 < PAGE; t0 += 8) {
            f32x4 k0[8], k1[8];
#pragma unroll
            for (int i = 0; i < 8; ++i) { k0[i] = __builtin_nontemporal_load((const f32x4*)(kb + (size_t)(t0 + i) * 512 + 4 * lane)); k1[i] = __builtin_nontemporal_load((const f32x4*)(kb + (size_t)(t0 + i) * 512 + 256 + 4 * lane)); }
#pragma unroll
            for (int i = 0; i < 8; ++i) {
                float d0 = k0[i][0] * q0[0] + k0[i][1] * q0[1] + k0[i][2] * q0[2] + k0[i][3] * q0[3];
                float d1 = k1[i][0] * q1[0] + k1[i][1] * q1[1] + k1[i][2] * q1[2] + k1[i][3] * q1[3];
                d0 += __shfl_xor(d0, 8); d1 += __shfl_xor(d1, 8); d0 += __shfl_xor(d0, 4); d1 += __shfl_xor(d1, 4);
                d0 += __shfl_xor(d0, 2); d1 += __shfl_xor(d1, 2); d0 += __shfl_xor(d0, 1); d1 += __shfl_xor(d1, 1);
                if ((lane & 15) == 0) { sc[(t0 + i) * 8 + (lane >> 4)] = d0; sc[(t0 + i) * 8 + 4 + (lane >> 4)] = d1; }
            }
        }
        LDS_WAIT();
        const int c = lane & 7; float mx = -INFINITY, sv[16];
#pragma unroll
        for (int i = 0; i < 16; ++i) { sv[i] = sc[((lane >> 3) + 8 * i) * 8 + c]; mx = fmaxf(mx, sv[i]); }
        mx = fmaxf(mx, __shfl_xor(mx, 8)); mx = fmaxf(mx, __shfl_xor(mx, 16)); mx = fmaxf(mx, __shfl_xor(mx, 32));
        float ls = 0.f;
#pragma unroll
        for (int i = 0; i < 16; ++i) { const float e = __expf(sv[i] - mx); ls += e; sc[((lane >> 3) + 8 * i) * 8 + c] = e; }
        ls += __shfl_xor(ls, 8); ls += __shfl_xor(ls, 16); ls += __shfl_xor(ls, 32);
        LDS_WAIT();
        const int h0 = lane >> 5, h1 = 2 + (lane >> 5);
        f32x4 o00 = {0.f, 0.f, 0.f, 0.f}, o01 = o00, o10 = o00, o11 = o00;
        for (int t0 = 0; t0 < PAGE; t0 += 8) {
            f32x4 v0[8], v1[8];
#pragma unroll
            for (int i = 0; i < 8; ++i) { v0[i] = __builtin_nontemporal_load((const f32x4*)(vb + (size_t)(t0 + i) * 512 + 4 * lane)); v1[i] = __builtin_nontemporal_load((const f32x4*)(vb + (size_t)(t0 + i) * 512 + 256 + 4 * lane)); }
#pragma unroll
            for (int i = 0; i < 8; ++i) { const f32x2 pa = *(const LAS f32x2*)(sc + (t0 + i) * 8 + 2 * h0), pb = *(const LAS f32x2*)(sc + (t0 + i) * 8 + 2 * h1);
                o00 += v0[i] * pa[0]; o01 += v0[i] * pa[1]; o10 += v1[i] * pb[0]; o11 += v1[i] * pb[1]; }
        }
        float* pp = PART + (size_t)wu * 8 * 132;
        *(f32x4*)(pp + (2 * h0) * 132 + 4 * (lane & 31)) = o00; *(f32x4*)(pp + (2 * h0 + 1) * 132 + 4 * (lane & 31)) = o01;
        *(f32x4*)(pp + (2 * h1) * 132 + 4 * (lane & 31)) = o10; *(f32x4*)(pp + (2 * h1 + 1) * 132 + 4 * (lane & 31)) = o11;
        if (lane < 8) { pp[lane * 132 + 128] = mx; pp[lane * 132 + 129] = ls; }
        LDS_WAIT();
    }
}
constexpr int CW_QUEUE = 8192;
constexpr unsigned NQ_UNITS = 32 + 512 + 256;
__device__ __forceinline__ void ph_queue(const Params& p, LAS unsigned char* lds, int bid, int nblk, int rep) {
    unsigned* qctr = (unsigned*)(p.ws + WS_CTL) + CW_QUEUE + 64 * rep;
    volatile LAS unsigned* slot = (volatile LAS unsigned*)(lds + MISC_OFF) + 16;
    for (;;) {
        __syncthreads();
        if (threadIdx.x == 0) slot[0] = __hip_atomic_fetch_add(qctr, 1u, __ATOMIC_RELAXED, __HIP_MEMORY_SCOPE_AGENT);
        __syncthreads();
        const unsigned u = (unsigned)__builtin_amdgcn_readfirstlane((int)slot[0]);
        if (u >= NQ_UNITS) break;
        int tid = threadIdx.x; asm volatile("" : "+v"(tid));
#ifndef QSKIP
#define QSKIP 0
#endif
        if (u < 32u) scan_unit(p, lds, (int)u, tid);
        else { const unsigned v = u - 32u; int ai = -1, di = -1;
            if (v < 512u) { if (v & 1u) di = (int)(v >> 1); else ai = (int)(v >> 1); } else ai = 256 + (int)(v - 512u);
            if (ai >= 0) { const int qb = 7 - (ai >> 6), bc = ai & 63; attn_unit((const bf16_t*)(p.ws + WS_H), (bf16_t*)(p.ws + WS_OA), lds, bc >> 3, bc & 7, qb, tid); }
            else { __syncthreads(); decode_wave_unit(p, lds, di * 8 + (tid >> 6), tid); } }
    }
}
__device__ __forceinline__ float lambda_of(const Params& p, int lane) {
    const float a = wave_sum(p.diff_lambda[lane] * p.diff_lambda[64 + lane]), b = wave_sum(p.diff_lambda[128 + lane] * p.diff_lambda[192 + lane]);
    return expf(a) - expf(b) + LAM_INIT;
}
__device__ __forceinline__ void ph_gate(const Params& p, LAS unsigned char* lds, int bid, int nblk) {
    const int tid = threadIdx.x, lane = tid & 63, wave = tid >> 6; const int gw = bid * 8 + wave, ngw = nblk * 8;
    const float lam = lambda_of(p, lane);
    const bf16_t* H = (const bf16_t*)(p.ws + WS_H); const bf16_t* OA = (const bf16_t*)(p.ws + WS_OA); const float* OB = (const float*)(p.ws + WS_OB);
    bf16_t* MIXIN = (bf16_t*)(p.ws + WS_MIXIN);
    const float nwa0 = p.diff_norm_w[2 * lane], nwa1 = p.diff_norm_w[2 * lane + 1];
    { const int h = lane >> 4, d8 = 8 * (lane & 15);
      float nwa[8], nwb[8];
#pragma unroll
      for (int e = 0; e < 8; ++e) { nwa[e] = p.diff_norm_w[d8 + e] * (1.f - LAM_INIT); nwb[e] = p.delta_norm_w[d8 + e]; }
      for (int row0 = gw * 2; row0 < MP; row0 += ngw * 2) {
          u32x4 a0[2], a1[2], ga[2], gb[2]; f32x4 ob0[2], ob1[2];
#pragma unroll
          for (int k = 0; k < 2; ++k) { const size_t row = (size_t)(row0 + k);
              a0[k] = *(const u32x4*)(OA + row * 1024 + (2 * h) * 128 + d8); a1[k] = *(const u32x4*)(OA + row * 1024 + (2 * h + 1) * 128 + d8);
              ga[k] = *(const u32x4*)(H + row * 4096 + 1536 + h * 128 + d8); gb[k] = *(const u32x4*)(H + row * 4096 + 3584 + h * 128 + d8);
              ob0[k] = *(const f32x4*)(OB + row * 512 + h * 128 + d8); ob1[k] = *(const f32x4*)(OB + row * 512 + h * 128 + d8 + 4); }
#pragma unroll
          for (int k = 0; k < 2; ++k) { const size_t row = (size_t)(row0 + k);
              float d[8], o[8], g1[8], g2[8]; float ssa = 0.f, ssb = 0.f;
#pragma unroll
              for (int e = 0; e < 4; ++e) { const unsigned x0 = a0[k][e], x1 = a1[k][e], y1 = ga[k][e], y2 = gb[k][e];
                  d[2 * e] = __uint_as_float(x0 << 16) - lam * __uint_as_float(x1 << 16); d[2 * e + 1] = __uint_as_float(x0 & 0xffff0000u) - lam * __uint_as_float(x1 & 0xffff0000u);
                  g1[2 * e] = __uint_as_float(y1 << 16); g1[2 * e + 1] = __uint_as_float(y1 & 0xffff0000u); g2[2 * e] = __uint_as_float(y2 << 16); g2[2 * e + 1] = __uint_as_float(y2 & 0xffff0000u);
                  o[e] = ob0[k][e]; o[4 + e] = ob1[k][e]; }
#pragma unroll
              for (int e = 0; e < 8; ++e) { ssa += d[e] * d[e]; ssb += o[e] * o[e]; }
#pragma unroll
              for (int m = 1; m < 16; m <<= 1) { ssa += __shfl_xor(ssa, m); ssb += __shfl_xor(ssb, m); }
              const float ra = rsqrtf(ssa * (1.f / 128.f) + 1e-5f), rb = rsqrtf(ssb * (1.f / 128.f) + 1e-6f);
              u32x4 wa, wb;
              wa.x = pk2f(d[0] * ra * nwa[0] * g1[0], d[1] * ra * nwa[1] * g1[1]); wa.y = pk2f(d[2] * ra * nwa[2] * g1[2], d[3] * ra * nwa[3] * g1[3]);
              wa.z = pk2f(d[4] * ra * nwa[4] * g1[4], d[5] * ra * nwa[5] * g1[5]); wa.w = pk2f(d[6] * ra * nwa[6] * g1[6], d[7] * ra * nwa[7] * g1[7]);
              wb.x = pk2f(o[0] * rb * nwb[0] * g2[0], o[1] * rb * nwb[1] * g2[1]); wb.y = pk2f(o[2] * rb * nwb[2] * g2[2], o[3] * rb * nwb[3] * g2[3]);
              wb.z = pk2f(o[4] * rb * nwb[4] * g2[4], o[5] * rb * nwb[5] * g2[5]); wb.w = pk2f(o[6] * rb * nwb[6] * g2[6], o[7] * rb * nwb[7] * g2[7]);
              *(u32x4*)(MIXIN + row * D + h * 128 + d8) = wa; *(u32x4*)(MIXIN + row * D + 512 + h * 128 + d8) = wb; }
      } }
    const float* QS = (const float*)(p.ws + WS_QS); const float* GSA = (const float*)(p.ws + WS_GSA); const float* PART = (const float*)(p.ws + WS_PART);
    for (int it = gw; it < NS * 4; it += ngw) {
        const int b = it >> 2, h = it & 3; float om[2][2];
#pragma unroll
        for (int m = 0; m < 2; ++m) {
            const int c = 2 * h + m;
            const float* pb = PART + ((size_t)(b * 64) * 8 + c) * 132;
            const float mpg = pb[(size_t)lane * 1056 + 128], lpg = pb[(size_t)lane * 1056 + 129];
            const float sself = wave_sum(QS[b * 512 + c * 64 + lane] * p.out[O_KS + b * 512 + c * 64 + lane]);
            float M = mpg;
#pragma unroll
            for (int o = 1; o < 64; o <<= 1) M = fmaxf(M, __shfl_xor(M, o));
            M = fmaxf(M, sself);
            const float wl = __expf(mpg - M), ws = __expf(sself - M);
            const float L = wave_sum(wl * lpg) + ws;
            float o0 = ws * p.out[O_VS + b * 512 + h * 128 + 2 * lane], o1 = ws * p.out[O_VS + b * 512 + h * 128 + 2 * lane + 1];
#pragma unroll 16
            for (int pg = 0; pg < NPAGES; ++pg) { const float w = __shfl(wl, pg); const f32x2 ov = *(const f32x2*)(pb + (size_t)pg * 1056 + 2 * lane); o0 += w * ov[0]; o1 += w * ov[1]; }
            om[m][0] = o0 / L; om[m][1] = o1 / L;
        }
        const float d0 = om[0][0] - lam * om[1][0], d1 = om[0][1] - lam * om[1][1];
        const float ra = rsqrtf(wave_sum(d0 * d0 + d1 * d1) * (1.f / 128.f) + 1e-5f) * (1.f - LAM_INIT);
        *(unsigned*)(MIXIN + (size_t)(MP + b) * D + h * 128 + 2 * lane) = pk2(d0 * ra * nwa0 * GSA[b * 512 + h * 128 + 2 * lane], d1 * ra * nwa1 * GSA[b * 512 + h * 128 + 2 * lane + 1]);
    }
}
__device__ __forceinline__ void ph_sample_outproj(const Params& p, LAS unsigned char* lds, int bid, int nblk) {
    const int tid = threadIdx.x, col = tid & 127, kq = tid >> 7;
    LAS float* as = (LAS float*)lds;
    LAS float* red = as + 8192;
    const bf16_t* MIXIN = (const bf16_t*)(p.ws + WS_MIXIN); float* MIXS = (float*)(p.ws + WS_MIXS);
    for (int u = bid; u < 32; u += nblk) {
        const int rg = u >> 3, cb = u & 7;
        __syncthreads();
        for (int i = tid; i < 8192; i += 512) as[i] = bf2f(MIXIN[(size_t)(MP + rg * 8 + (i >> 10)) * D + (i & 1023)]);
        __syncthreads();
        float acc[8];
#pragma unroll
        for (int r = 0; r < 8; ++r) acc[r] = 0.f;
        for (int k = kq * 256; k < kq * 256 + 256; ++k) { const float w = p.w_out[(size_t)k * D + cb * 128 + col];
#pragma unroll
            for (int r = 0; r < 8; ++r) acc[r] += as[r * 1024 + k] * w; }
#pragma unroll
        for (int r = 0; r < 8; ++r) red[(kq * 8 + r) * 128 + col] = acc[r];
        __syncthreads();
        for (int i = tid; i < 1024; i += 512) { const int r = i >> 7, cc = i & 127;
            MIXS[(size_t)(rg * 8 + r) * D + cb * 128 + cc] = red[(0 * 8 + r) * 128 + cc] + red[(1 * 8 + r) * 128 + cc] + red[(2 * 8 + r) * 128 + cc] + red[(3 * 8 + r) * 128 + cc]; }
    }
}
__device__ __forceinline__ void ph_ln(const Params& p, int bid, int nblk) {
    const int tid = threadIdx.x, lane = tid & 63, wave = tid >> 6; const int gw = bid * 8 + wave, ngw = nblk * 8;
    const float* MIX = (const float*)(p.ws + WS_MIX); const float* MIXS = (const float*)(p.ws + WS_MIXS);
    const float alpha = 1.189207115002721f;
    for (int row = gw; row < MP + NS; row += ngw) {
        const float* xr = row < MP ? p.x_prompt + (size_t)row * D : p.x_sample + (size_t)(row - MP) * D;
        const float* mr = row < MP ? MIX + (size_t)row * D : MIXS + (size_t)(row - MP) * D;
        float* orow = row < MP ? p.out + O_Y + (size_t)row * D : p.out + O_YS + (size_t)(row - MP) * D;
        f32x4 v[4]; float s = 0.f;
#pragma unroll
        for (int j = 0; j < 4; ++j) { const f32x4 xv = *(const f32x4*)(xr + 4 * lane + 256 * j), mv = *(const f32x4*)(mr + 4 * lane + 256 * j); v[j] = xv * alpha + mv; s += (v[j][0] + v[j][1]) + (v[j][2] + v[j][3]); }
        const float mean = wave_sum(s) * (1.f / D); float s2 = 0.f;
#pragma unroll
        for (int j = 0; j < 4; ++j) { v[j] = v[j] - mean; s2 += (v[j][0] * v[j][0] + v[j][1] * v[j][1]) + (v[j][2] * v[j][2] + v[j][3] * v[j][3]); }
        const float rstd = rsqrtf(wave_sum(s2) * (1.f / D) + 1e-5f);
#pragma unroll
        for (int j = 0; j < 4; ++j) { const f32x4 gv = *(const f32x4*)(p.ln_g + 4 * lane + 256 * j), bv = *(const f32x4*)(p.ln_b + 4 * lane + 256 * j); *(f32x4*)(orow + 4 * lane + 256 * j) = v[j] * rstd * gv + bv; }
    }
}
#ifndef N_LAUNCHES
#define N_LAUNCHES 1
#endif
constexpr int N_PHASES = 9;
__global__ void __launch_bounds__(512, 2) fwd_kernel(Params p) {
    extern __shared__ __attribute__((aligned(16))) unsigned char lds_raw[];
    LAS unsigned char* lds = (LAS unsigned char*)lds_raw;
    const int tid = threadIdx.x, bid = blockIdx.x, nblk = gridDim.x;
    for (int u = tid; u < (LDS_BYTES - 131072) / 4; u += 512) ((LAS unsigned*)(lds + 131072))[u] = 0u;
    __syncthreads();
    XcdBarrier bar; bar.bar = (unsigned*)(p.ws + WS_CTL) + CW_BAR; bar.x = 0; bar.st = nullptr;
    if (N_LAUNCHES == 1) bar = xcd_barrier_post((unsigned*)(p.ws + WS_CTL) + CW_BAR, (volatile LAS unsigned*)(lds + MISC_OFF) + 8);
    const int lo = p.ph_lo, hi = p.ph_hi;
#ifndef PHASE_MASK
#define PHASE_MASK 0xffff
#endif
#define IN(k) (((PHASE_MASK >> (k)) & 1) && lo <= (k) && (k) < hi)
#ifndef REPEAT_PHASE
#define REPEAT_PHASE -1
#endif
#define REP(k, body) do { body; if (REPEAT_PHASE == (k)) { xcd_barrier(bar); body; } } while (0)
#define SEAM(k) do { if (IN(k) && IN((k) + 1)) { if (N_LAUNCHES == 1) xcd_barrier(bar); } else __syncthreads(); } while (0)
    if (IN(0)) REP(0, ph_prologue(p, lds, bid, nblk));
    SEAM(0);
    if (IN(1)) {
        pg8::Gemm g{(const bf16_t*)(p.ws + WS_XB), (const bf16_t*)(p.ws + WS_WTIN), MP, NH, D}; pg8::StaticOrder S; S.init(MP, NH, nblk, bid);
        pg8::EpiH E{(bf16_t*)(p.ws + WS_H), p.out, (const float*)(p.ws + WS_ROPE)};
        REP(1, (pg8::gemm_phase<pg8::EpiH, pg8::StaticOrder, true, true>(lds, g, S, E)));
    }
    __syncthreads();
    if (IN(2)) REP(2, ph_sample_post(p, lds, bid, nblk));
    SEAM(2);
    if (IN(3)) { ph_delta_prep(p, lds, bid, nblk, 0); if (REPEAT_PHASE == 3) { xcd_barrier(bar); ph_delta_prep(p, lds, bid, nblk, 1); } }
    SEAM(3);
    if (IN(4)) { ph_queue(p, lds, bid, nblk, 0); if (REPEAT_PHASE == 4) { xcd_barrier(bar); ph_queue(p, lds, bid, nblk, 1); } }
    SEAM(4);
    if (IN(5)) REP(5, ph_gate(p, lds, bid, nblk));
    SEAM(5);
    if (IN(6)) {
        pg8::Gemm g{(const bf16_t*)(p.ws + WS_MIXIN), (const bf16_t*)(p.ws + WS_WTOUT), MP, D, D}; pg8::StaticOrder S; S.init(MP, D, nblk, bid);
        pg8::EpiF32 E{(float*)(p.ws + WS_MIX), D};
        REP(6, (pg8::gemm_phase<pg8::EpiF32, pg8::StaticOrder, true, true>(lds, g, S, E)));
    }
    __syncthreads();
    if (IN(7)) REP(7, ph_sample_outproj(p, lds, bid, nblk));
    SEAM(7);
    if (IN(8)) REP(8, ph_ln(p, bid, nblk));
#undef IN
#undef SEAM
}

extern "C" void kernel_launch(void* const* d_in, const int* in_sizes, int n_in, void* d_out, int out_size, void* d_ws, size_t ws_size, hipStream_t stream) {
    static int grid = 0;
    if (grid == 0) {
        if (n_in != 17 || out_size != O_END || ws_size < WS_END) { fprintf(stderr, "kernel_launch: unexpected sizes (n_in %d out %d ws %zu)\n", n_in, out_size, ws_size); grid = -1; return; }
        int dev = 0, cus = 0, per_cu = 0;
        if (hipGetDevice(&dev) != hipSuccess || hipDeviceGetAttribute(&cus, hipDeviceAttributeMultiprocessorCount, dev) != hipSuccess) { grid = -1; return; }
        if (hipFuncSetAttribute((const void*)fwd_kernel, hipFuncAttributeMaxDynamicSharedMemorySize, LDS_BYTES) != hipSuccess) { fprintf(stderr, "kernel_launch: hipFuncSetAttribute failed\n"); grid = -1; return; }
        if (hipOccupancyMaxActiveBlocksPerMultiprocessor(&per_cu, (const void*)fwd_kernel, 512, LDS_BYTES) != hipSuccess || per_cu < 1) fprintf(stderr, "kernel_launch: occupancy query says %d\n", per_cu);
        (void)hipGetLastError();
        grid = cus;
    }
    if (grid < 0) return;
    (void)hipMemsetAsync((char*)d_ws + WS_CTL, 0, CTL_ZERO_BYTES, stream);
    Params p{};
    p.x_prompt = (const float*)d_in[0]; p.x_sample = (const float*)d_in[1]; p.cache_k = (const float*)d_in[2]; p.cache_v = (const float*)d_in[3]; p.page_table = (const int*)d_in[4];
    p.state_delta = (const float*)d_in[5]; p.state_conv = (const float*)d_in[6]; p.w_in = (const float*)d_in[7]; p.conv_w = (const float*)d_in[8]; p.a_log = (const float*)d_in[9];
    p.dt_bias = (const float*)d_in[10]; p.delta_norm_w = (const float*)d_in[11]; p.diff_lambda = (const float*)d_in[12]; p.diff_norm_w = (const float*)d_in[13]; p.w_out = (const float*)d_in[14];
    p.ln_g = (const float*)d_in[15]; p.ln_b = (const float*)d_in[16]; p.out = (float*)d_out; p.ws = (unsigned char*)d_ws;
    const int cuts6[8] = {0, 1, 3, 4, 5, 6, 8, 9};
    const int nl = (N_LAUNCHES == 1) ? 1 : 7;
    for (int li = 0; li < nl; ++li) {
        p.ph_lo = (N_LAUNCHES == 1) ? 0 : cuts6[li]; p.ph_hi = (N_LAUNCHES == 1) ? N_PHASES : cuts6[li + 1];
        hipLaunchKernelGGL(fwd_kernel, dim3(grid), dim3(512), LDS_BYTES, stream, p);
        const hipError_t le = hipPeekAtLastError();
        if (le != hipSuccess) { fprintf(stderr, "kernel_launch: launch %d failed: %s\n", li, hipGetErrorName(le)); break; }
    }
}
```
